# Optimizing an MI355X kernel written in HIP

```python
import math
import jax
import jax.numpy as jnp
from jax import lax
import numpy as np

D_MODEL = 1024
BATCH = 4
SEQ = 8192
DEPTH = 2

CTX_LEN = 256
GRID_W = 64
EPS = 1e-6
ROPE_BASE = 10000.0
ROT_DIM = 64
Q_BLOCK = 128

DA_HEADS = 4
DA_HEAD_DIM = ROT_DIM
DA_V_DIM = 2 * DA_HEAD_DIM
DA_QK_COLS = DA_HEADS * 2 * DA_HEAD_DIM
DA_WIDTH = DA_HEADS * DA_V_DIM

SSD_HEADS = 8
SSD_HEAD_DIM = 64
SSD_INNER = SSD_HEADS * SSD_HEAD_DIM
SSD_GROUPS = 2
SSD_STATE = 128
SSD_CONV = 5
SSD_CHUNK = 128
SSD_XBC = SSD_INNER + 2 * SSD_GROUPS * SSD_STATE

MLA_HEADS = 4
MLA_Q_LORA = 384
MLA_KV_LORA = 256
MLA_NOPE = 128
MLA_ROPE = ROT_DIM
MLA_V = 128
MLA_WIDTH = MLA_HEADS * MLA_V

HY_WIDTH = 512
HY_ORDER = 2
HY_SHORT = 3
HY_EMB = 33
HY_HIDDEN = 64
HY_TARGET = 1e-2
HY_DECAY_SHORT = 0.3
HY_DECAY_LONG = 1.5

N_BRANCH = 4
COLS_DA = 2 * DA_QK_COLS + DA_WIDTH
COLS_SSD = SSD_INNER + SSD_XBC + 2 * SSD_HEADS
COLS_MLA = MLA_Q_LORA + MLA_KV_LORA + MLA_ROPE
COLS_HY = (HY_ORDER + 1) * HY_WIDTH
COLS_GATE = N_BRANCH * D_MODEL
IN_COLS = COLS_DA + COLS_SSD + COLS_MLA + COLS_HY + COLS_GATE

FFN_HIDDEN = -(-8 * D_MODEL // (3 * 256)) * 256

kernel_name = 'hybrid_diffusion_prefix_block'


def rmsnorm(x, g):
    xf = x.astype(jnp.float32)
    y = xf * lax.rsqrt(jnp.mean(xf * xf, axis=-1, keepdims=True) + EPS)
    return (y * g.astype(jnp.float32)).astype(x.dtype)


def modulate(h, shift, scale):
    return h * (1.0 + scale) + shift


def dwconv(u, w, b):
    k, ch = w.shape
    y = lax.conv_general_dilated(u, w[:, None, :].astype(u.dtype), window_strides=(1,),
                                 padding=[(k // 2, k // 2)],
                                 dimension_numbers=('NWC', 'WIO', 'NWC'),
                                 feature_group_count=ch)
    return y + b.astype(u.dtype)


def split_cols(p):
    offs = np.cumsum([COLS_DA, COLS_SSD, COLS_MLA, COLS_HY]).tolist()
    return jnp.split(p, offs, axis=-1)


def axial_rope_tables(rows):
    t = jnp.arange(rows * GRID_W)
    pos_row = (t // GRID_W).astype(jnp.float32)
    pos_col = (t % GRID_W).astype(jnp.float32)
    quarter = ROT_DIM // 4
    inv = ROPE_BASE ** (-jnp.arange(quarter, dtype=jnp.float32) / quarter)
    ang = jnp.concatenate([pos_row[:, None] * inv, pos_col[:, None] * inv], axis=-1)
    return jnp.cos(ang), jnp.sin(ang)


def apply_rope(x, cos, sin):
    shape = (1, x.shape[1]) + (1,) * (x.ndim - 3) + (x.shape[-1] // 2,)
    c = cos.reshape(shape).astype(x.dtype)
    s = sin.reshape(shape).astype(x.dtype)
    x1, x2 = jnp.split(x, 2, axis=-1)
    return jnp.concatenate([x1 * c - x2 * s, x2 * c + x1 * s], axis=-1)


def sweep_query_blocks(fn, *qs):
    b, n = qs[0].shape[:2]
    nb = n // Q_BLOCK
    blocks = tuple(jnp.moveaxis(q.reshape((b, nb, Q_BLOCK) + q.shape[2:]), 1, 0) for q in qs)
    out = lax.map(lambda args: fn(*args), blocks)
    return jnp.moveaxis(out, 0, 1).reshape((b, n) + out.shape[3:])


def diff_attention(q, k, v, lam):
    scale = DA_HEAD_DIM ** -0.5

    def block(qb):
        s = jnp.einsum('bqhcd,bkhcd->bhcqk', qb, k)
        p = jax.nn.softmax(s.astype(jnp.float32) * scale, axis=-1)
        w = (p[:, :, 0] - lam * p[:, :, 1]).astype(v.dtype)
        return jnp.einsum('bhqk,bkhe->bqhe', w, v)

    return sweep_query_blocks(block, q)


def da_project(cols, rope_cs):
    b, n = cols.shape[:2]
    q, k, v = jnp.split(cols, [DA_QK_COLS, 2 * DA_QK_COLS], axis=-1)
    q = q.reshape(b, n, DA_HEADS, 2, DA_HEAD_DIM)
    k = k.reshape(b, n, DA_HEADS, 2, DA_HEAD_DIM)
    v = v.reshape(b, n, DA_HEADS, DA_V_DIM)
    if rope_cs is not None:
        q = apply_rope(q, *rope_cs)
        k = apply_rope(k, *rope_cs)
    return q, k, v


def diff_attn_branch(cols_lat, cols_ctx, lp, lam_init, rope_cs, need_ctx):
    q_l, k_l, v_l = da_project(cols_lat, rope_cs)
    q_c, k_c, v_c = da_project(cols_ctx, None)
    lv = lp['da_lambda'].astype(jnp.float32)
    lam = jnp.exp(jnp.sum(lv[0] * lv[1])) - jnp.exp(jnp.sum(lv[2] * lv[3])) + lam_init

    def finish(o):
        o = rmsnorm(o, lp['da_subln']) * (1.0 - lam_init)
        return o.reshape(o.shape[0], o.shape[1], DA_WIDTH)

    o_lat = finish(diff_attention(q_l, jnp.concatenate([k_c, k_l], axis=1),
                                  jnp.concatenate([v_c, v_l], axis=1), lam))
    o_ctx = finish(diff_attention(q_c, k_c, v_c, lam)) if need_ctx else None
    return o_lat, o_ctx


def segsum(a):
    t = a.shape[-1]
    cs = jnp.cumsum(a, axis=-1)
    d = cs[..., :, None] - cs[..., None, :]
    return jnp.where(jnp.tril(jnp.ones((t, t), dtype=bool)), d, -jnp.inf)


def ssd_scan(xh, dt, a_head, bm, cm, init):
    b, l, h, p = xh.shape
    rep = h // bm.shape[2]
    nc = l // SSD_CHUNK
    bh = jnp.repeat(bm, rep, axis=2).reshape(b, nc, SSD_CHUNK, h, -1)
    ch = jnp.repeat(cm, rep, axis=2).reshape(b, nc, SSD_CHUNK, h, -1)
    xdt = (xh * dt[..., None]).reshape(b, nc, SSD_CHUNK, h, p)
    a = jnp.moveaxis((dt * a_head).reshape(b, nc, SSD_CHUNK, h), 3, 1)
    a_cum = jnp.cumsum(a, axis=-1)
    scores = jnp.einsum('bclhn,bcshn->bhcls', ch, bh) * jnp.exp(segsum(a))
    y_diag = jnp.einsum('bhcls,bcshp->bclhp', scores, xdt)
    decay_to_end = jnp.exp(a_cum[..., -1:] - a_cum)
    chunk_states = jnp.einsum('bclhn,bhcl,bclhp->bchpn', bh, decay_to_end, xdt)
    chunk_decay = jnp.exp(a_cum[..., -1])

    def step(s, inp):
        st, dec = inp
        return s * dec[..., None, None] + st, s

    final, prev = lax.scan(step, init, (jnp.moveaxis(chunk_states, 1, 0), jnp.moveaxis(chunk_decay, 2, 0)))
    y_off = jnp.einsum('bclhn,cbhpn,bhcl->bclhp', ch, prev, jnp.exp(a_cum))
    return (y_diag + y_off).reshape(b, l, h, p), final


def ssd_sequence(xbc, dt_raw, lp, init_f, init_b):
    f32 = jnp.float32
    b, n = xbc.shape[:2]
    xbc = jax.nn.silu(dwconv(xbc, lp['ssd_conv_w'], lp['ssd_conv_b']).astype(f32))
    xs, bm, cm = jnp.split(xbc, [SSD_INNER, SSD_INNER + SSD_GROUPS * SSD_STATE], axis=-1)
    xh = xs.reshape(b, n, SSD_HEADS, SSD_HEAD_DIM)
    bm = bm.reshape(b, n, SSD_GROUPS, SSD_STATE)
    cm = cm.reshape(b, n, SSD_GROUPS, SSD_STATE)
    dt = jax.nn.softplus(dt_raw.astype(f32).reshape(b, n, 2, SSD_HEADS) + lp['ssd_dt_bias'].astype(f32))
    a = -jnp.exp(lp['ssd_a_log'].astype(f32))
    y_f, s_f = ssd_scan(xh, dt[:, :, 0], a[0], bm, cm, init_f)
    rev = lambda t: jnp.flip(t, axis=1)
    y_b, s_b = ssd_scan(rev(xh), rev(dt[:, :, 1]), a[1], rev(bm), rev(cm), init_b)
    y = y_f + rev(y_b) + lp['ssd_d'].astype(f32)[:, None] * xh
    return y.reshape(b, n, SSD_INNER), s_f, s_b


def ssd_branch(cols_lat, cols_ctx, lp, need_ctx):
    z_l, xbc_l, dt_l = jnp.split(cols_lat, [SSD_INNER, SSD_INNER + SSD_XBC], axis=-1)
    z_c, xbc_c, dt_c = jnp.split(cols_ctx, [SSD_INNER, SSD_INNER + SSD_XBC], axis=-1)
    zeros = jnp.zeros((cols_lat.shape[0], SSD_HEADS, SSD_HEAD_DIM, SSD_STATE), jnp.float32)
    y_c, s_f, s_b = ssd_sequence(xbc_c, dt_c, lp, zeros, zeros)
    y_l, _, _ = ssd_sequence(xbc_l, dt_l, lp, s_f, s_b)

    def finish(y, z):
        return rmsnorm(y * jax.nn.silu(z.astype(jnp.float32)), lp['ssd_norm']).astype(z.dtype)

    return finish(y_l, z_l), (finish(y_c, z_c) if need_ctx else None)


def mla_attention(q_nope, q_rope, k_nope, k_rope, v):
    scale = (MLA_NOPE + MLA_ROPE) ** -0.5

    def block(qn, qr):
        s = jnp.einsum('bqhd,bkhd->bhqk', qn, k_nope) + jnp.einsum('bqhr,bkr->bhqk', qr, k_rope)
        p = jax.nn.softmax(s.astype(jnp.float32) * scale, axis=-1).astype(v.dtype)
        return jnp.einsum('bhqk,bkhe->bqhe', p, v)

    return sweep_query_blocks(block, q_nope, q_rope)


def mla_project(cols, lp, rope_cs):
    b, n = cols.shape[:2]
    cq, ckv, kr = jnp.split(cols, [MLA_Q_LORA, MLA_Q_LORA + MLA_KV_LORA], axis=-1)
    q = (rmsnorm(cq, lp['mla_q_norm']) @ lp['mla_w_uq']).reshape(b, n, MLA_HEADS, MLA_NOPE + MLA_ROPE)
    kv = (rmsnorm(ckv, lp['mla_kv_norm']) @ lp['mla_w_ukv']).reshape(b, n, MLA_HEADS, MLA_NOPE + MLA_V)
    q_nope, q_rope = jnp.split(q, [MLA_NOPE], axis=-1)
    k_nope, v = jnp.split(kv, [MLA_NOPE], axis=-1)
    if rope_cs is not None:
        q_rope = apply_rope(q_rope, *rope_cs)
        kr = apply_rope(kr, *rope_cs)
    return q_nope, q_rope, k_nope, kr, v


def mla_branch(cols_lat, cols_ctx, lp, rope_cs, need_ctx):
    qn_l, qr_l, kn_l, kr_l, v_l = mla_project(cols_lat, lp, rope_cs)
    qn_c, qr_c, kn_c, kr_c, v_c = mla_project(cols_ctx, lp, None)
    b = cols_lat.shape[0]
    o_lat = mla_attention(qn_l, qr_l, jnp.concatenate([kn_c, kn_l], axis=1),
                          jnp.concatenate([kr_c, kr_l], axis=1), jnp.concatenate([v_c, v_l], axis=1))
    o_lat = o_lat.reshape(b, -1, MLA_WIDTH)
    o_ctx = mla_attention(qn_c, qr_c, kn_c, kr_c, v_c).reshape(b, -1, MLA_WIDTH) if need_ctx else None
    return o_lat, o_ctx


def hyena_filter_spectrum(n, lp):
    f32 = jnp.float32
    t = jnp.arange(n, dtype=f32)
    t_unit = t / (n - 1)
    bands = (HY_EMB - 1) // 2
    band_f = jnp.linspace(1e-4, bands - 1, bands, dtype=f32)
    w = 2.0 * math.pi * t / n
    feats = jnp.concatenate([t_unit[:, None], jnp.cos(w[:, None] * band_f), -jnp.sin(w[:, None] * band_f)], axis=-1)
    hid = jnp.sin(lp['hy_freq1'].astype(f32) * (feats @ lp['hy_w1'].astype(f32) + lp['hy_b1'].astype(f32)))
    hid = jnp.sin(lp['hy_freq2'].astype(f32) * (hid @ lp['hy_w2'].astype(f32) + lp['hy_b2'].astype(f32)))
    h = (hid @ lp['hy_w3'].astype(f32)).reshape(n, 2, HY_ORDER, HY_WIDTH)
    deltas = jnp.abs(jnp.linspace(math.log(HY_TARGET) / HY_DECAY_LONG, math.log(HY_TARGET) / HY_DECAY_SHORT,
                                  HY_WIDTH, dtype=f32))
    h = h * jnp.exp(-t_unit[:, None] * deltas)[:, None, None, :]
    fwd, bwd = h[:, 0], h[:, 1]
    g = jnp.concatenate([fwd[:1] + bwd[:1], fwd[1:], jnp.zeros_like(fwd[:1]), jnp.flip(bwd[1:], axis=0)], axis=0)
    g = g * lax.rsqrt(jnp.sum(g * g, axis=0, keepdims=True) + EPS)
    return jnp.fft.rfft(g, axis=0)


def fft_conv(u, spec):
    n = u.shape[1]
    y = jnp.fft.irfft(jnp.fft.rfft(u, n=2 * n, axis=1) * spec[None], n=2 * n, axis=1)
    return y[:, :n]


def hyena_sequence(cols, lp):
    n = cols.shape[1]
    u = dwconv(cols, lp['hy_conv_w'], lp['hy_conv_b']).astype(jnp.float32)
    v, x1, x2 = jnp.split(u, HY_ORDER + 1, axis=-1)
    spec = hyena_filter_spectrum(n, lp)
    bias = lp['hy_bias'].astype(jnp.float32)
    z = v
    for o, gate in enumerate((x1, x2)):
        z = gate * (fft_conv(z, spec[:, o]) + bias[o] * z)
    return z.astype(cols.dtype)


def hyena_branch(cols_lat, cols_ctx, lp, need_ctx):
    return hyena_sequence(cols_lat, lp), (hyena_sequence(cols_ctx, lp) if need_ctx else None)


def merge_branches(outs, gate_cols, w_brs, w_out):
    gates = jnp.split(jax.nn.sigmoid(gate_cols), N_BRANCH, axis=-1)
    mixed = sum(g * (o @ w) for g, o, w in zip(gates, outs, w_brs))
    return mixed @ w_out


def token_mixer(h_lat, h_ctx, lp, lam_init, rope_cs, need_ctx):
    da_l, ssd_l, mla_l, hy_l, gate_l = split_cols(h_lat @ lp['w_in'])
    da_c, ssd_c, mla_c, hy_c, gate_c = split_cols(h_ctx @ lp['w_in'])
    branches = (
        diff_attn_branch(da_l, da_c, lp, lam_init, rope_cs, need_ctx),
        ssd_branch(ssd_l, ssd_c, lp, need_ctx),
        mla_branch(mla_l, mla_c, lp, rope_cs, need_ctx),
        hyena_branch(hy_l, hy_c, lp, need_ctx),
    )
    w_brs = (lp['w_br_da'], lp['w_br_ssd'], lp['w_br_mla'], lp['w_br_hy'])
    y_lat = merge_branches([br[0] for br in branches], gate_l, w_brs, lp['w_out'])
    y_ctx = merge_branches([br[1] for br in branches], gate_c, w_brs, lp['w_out']) if need_ctx else None
    return y_lat, y_ctx


def swiglu(h, w1, w3, w2):
    return (jax.nn.silu(h @ w1) * (h @ w3)) @ w2


def setup_inputs(seed: int = 0) -> dict:
    key = jax.random.key(seed)
    keys = iter(jax.random.split(key, 64))
    f32 = jnp.float32
    L = DEPTH

    def normal(shape, scale):
        return scale * jax.random.normal(next(keys), shape, f32)

    def gain(shape):
        return 1.0 + normal(shape, 0.05)

    dt0 = jnp.exp(jax.random.uniform(next(keys), (L, 2, SSD_HEADS), f32, math.log(1e-3), math.log(1e-1)))
    a0 = jax.random.uniform(next(keys), (L, 2, SSD_HEADS), f32, 1.0, 16.0)
    return {
        'x': normal((BATCH, SEQ, D_MODEL), 1.0),
        'c': normal((BATCH, D_MODEL), 1.0),
        'ctx': normal((BATCH, CTX_LEN, D_MODEL), 1.0),
        'c_ctx': normal((D_MODEL,), 1.0),
        'mod_w': normal((L, D_MODEL, 6 * D_MODEL), 0.5 * D_MODEL ** -0.5),
        'mod_b': normal((L, 6 * D_MODEL), 0.02),
        'norm_mix_pre': gain((L, D_MODEL)),
        'norm_mix_post': gain((L, D_MODEL)),
        'norm_ffn_pre': gain((L, D_MODEL)),
        'norm_ffn_post': gain((L, D_MODEL)),
        'w_in': normal((L, D_MODEL, IN_COLS), D_MODEL ** -0.5),
        'da_lambda': normal((L, 4, DA_HEAD_DIM), 0.1),
        'da_subln': gain((L, DA_V_DIM)),
        'ssd_conv_w': normal((L, SSD_CONV, SSD_XBC), SSD_CONV ** -0.5),
        'ssd_conv_b': normal((L, SSD_XBC), 0.02),
        'ssd_a_log': jnp.log(a0),
        'ssd_dt_bias': dt0 + jnp.log(-jnp.expm1(-dt0)),
        'ssd_d': 1.0 + normal((L, SSD_HEADS), 0.1),
        'ssd_norm': gain((L, SSD_INNER)),
        'mla_q_norm': gain((L, MLA_Q_LORA)),
        'mla_w_uq': normal((L, MLA_Q_LORA, MLA_HEADS * (MLA_NOPE + MLA_ROPE)), MLA_Q_LORA ** -0.5),
        'mla_kv_norm': gain((L, MLA_KV_LORA)),
        'mla_w_ukv': normal((L, MLA_KV_LORA, MLA_HEADS * (MLA_NOPE + MLA_V)), MLA_KV_LORA ** -0.5),
        'hy_conv_w': normal((L, HY_SHORT, COLS_HY), HY_SHORT ** -0.5),
        'hy_conv_b': normal((L, COLS_HY), 0.02),
        'hy_w1': normal((L, HY_EMB, HY_HIDDEN), HY_EMB ** -0.5),
        'hy_b1': normal((L, HY_HIDDEN), 0.02),
        'hy_freq1': 1.0 + normal((L, HY_HIDDEN), 0.1),
        'hy_w2': normal((L, HY_HIDDEN, HY_HIDDEN), HY_HIDDEN ** -0.5),
        'hy_b2': normal((L, HY_HIDDEN), 0.02),
        'hy_freq2': 1.0 + normal((L, HY_HIDDEN), 0.1),
        'hy_w3': normal((L, HY_HIDDEN, 2 * HY_ORDER * HY_WIDTH), HY_HIDDEN ** -0.5),
        'hy_bias': normal((L, HY_ORDER, HY_WIDTH), 0.5),
        'w_br_da': normal((L, DA_WIDTH, D_MODEL), DA_WIDTH ** -0.5),
        'w_br_ssd': normal((L, SSD_INNER, D_MODEL), SSD_INNER ** -0.5),
        'w_br_mla': normal((L, MLA_WIDTH, D_MODEL), MLA_WIDTH ** -0.5),
        'w_br_hy': normal((L, HY_WIDTH, D_MODEL), HY_WIDTH ** -0.5),
        'w_out': normal((L, D_MODEL, D_MODEL), D_MODEL ** -0.5),
        'ffn_w1': normal((L, D_MODEL, FFN_HIDDEN), D_MODEL ** -0.5),
        'ffn_w3': normal((L, D_MODEL, FFN_HIDDEN), D_MODEL ** -0.5),
        'ffn_w2': normal((L, FFN_HIDDEN, D_MODEL), FFN_HIDDEN ** -0.5),
    }


def reference(x, c, ctx, c_ctx, mod_w, mod_b, norm_mix_pre, norm_mix_post, norm_ffn_pre,
              norm_ffn_post, w_in, da_lambda, da_subln, ssd_conv_w, ssd_conv_b, ssd_a_log,
              ssd_dt_bias, ssd_d, ssd_norm, mla_q_norm, mla_w_uq, mla_kv_norm, mla_w_ukv,
              hy_conv_w, hy_conv_b, hy_w1, hy_b1, hy_freq1, hy_w2, hy_b2, hy_freq2, hy_w3,
              hy_bias, w_br_da, w_br_ssd, w_br_mla, w_br_hy, w_out, ffn_w1, ffn_w3, ffn_w2):
    n_lat = x.shape[1]
    rows = n_lat // GRID_W
    rope_cs = axial_rope_tables(rows)
    c_act = jax.nn.silu(c)
    cc_act = jax.nn.silu(c_ctx)
    x_lat, x_ctx = x, ctx
    for l in range(DEPTH):
        last = l == DEPTH - 1
        lp = {
            'w_in': w_in[l], 'da_lambda': da_lambda[l], 'da_subln': da_subln[l],
            'ssd_conv_w': ssd_conv_w[l], 'ssd_conv_b': ssd_conv_b[l], 'ssd_a_log': ssd_a_log[l],
            'ssd_dt_bias': ssd_dt_bias[l], 'ssd_d': ssd_d[l], 'ssd_norm': ssd_norm[l],
            'mla_q_norm': mla_q_norm[l], 'mla_w_uq': mla_w_uq[l], 'mla_kv_norm': mla_kv_norm[l],
            'mla_w_ukv': mla_w_ukv[l], 'hy_conv_w': hy_conv_w[l], 'hy_conv_b': hy_conv_b[l],
            'hy_w1': hy_w1[l], 'hy_b1': hy_b1[l], 'hy_freq1': hy_freq1[l], 'hy_w2': hy_w2[l],
            'hy_b2': hy_b2[l], 'hy_freq2': hy_freq2[l], 'hy_w3': hy_w3[l], 'hy_bias': hy_bias[l],
            'w_br_da': w_br_da[l], 'w_br_ssd': w_br_ssd[l], 'w_br_mla': w_br_mla[l],
            'w_br_hy': w_br_hy[l], 'w_out': w_out[l],
        }
        lam_init = 0.8 - 0.6 * math.exp(-0.3 * l)
        mod_lat = jnp.split((c_act @ mod_w[l] + mod_b[l])[:, None, :], 6, axis=-1)
        mod_ctx = jnp.split(cc_act @ mod_w[l] + mod_b[l], 6, axis=-1)
        h_lat = modulate(rmsnorm(x_lat, norm_mix_pre[l]), mod_lat[0], mod_lat[1])
        h_ctx = modulate(rmsnorm(x_ctx, norm_mix_pre[l]), mod_ctx[0], mod_ctx[1])
        y_lat, y_ctx = token_mixer(h_lat, h_ctx, lp, lam_init, rope_cs, not last)
        x_lat = x_lat + mod_lat[2] * rmsnorm(y_lat, norm_mix_post[l])
        f_lat = swiglu(modulate(rmsnorm(x_lat, norm_ffn_pre[l]), mod_lat[3], mod_lat[4]),
                       ffn_w1[l], ffn_w3[l], ffn_w2[l])
        x_lat = x_lat + mod_lat[5] * rmsnorm(f_lat, norm_ffn_post[l])
        if not last:
            x_ctx = x_ctx + mod_ctx[2] * rmsnorm(y_ctx, norm_mix_post[l])
            f_ctx = swiglu(modulate(rmsnorm(x_ctx, norm_ffn_pre[l]), mod_ctx[3], mod_ctx[4]),
                           ffn_w1[l], ffn_w3[l], ffn_w2[l])
            x_ctx = x_ctx + mod_ctx[5] * rmsnorm(f_ctx, norm_ffn_post[l])
    return x_lat
```

```cpp
#include <hip/hip_runtime.h>
#include <hip/hip_cooperative_groups.h>
#include <cstdio>
#include <cstdint>
namespace cg = cooperative_groups;

#ifndef MEGA
#define MEGA 1
#endif

#define DI __device__ __forceinline__
typedef unsigned short u16;
typedef __attribute__((ext_vector_type(8))) short bf16x8;
typedef __attribute__((ext_vector_type(16))) float f32x16;
typedef __attribute__((ext_vector_type(4))) unsigned U4;
typedef __attribute__((ext_vector_type(2))) unsigned U2;
typedef __attribute__((ext_vector_type(4))) float F4;
typedef __attribute__((ext_vector_type(2))) float F2;
__device__ __forceinline__ U4 mku4(unsigned a, unsigned b, unsigned c, unsigned d) { U4 v = {a, b, c, d}; return v; }
__device__ __forceinline__ U2 mku2(unsigned a, unsigned b) { U2 v = {a, b}; return v; }
__device__ __forceinline__ F4 mkf4(float a, float b, float c, float d) { F4 v = {a, b, c, d}; return v; }
__device__ __forceinline__ F2 mkf2(float a, float b) { F2 v = {a, b}; return v; }
#define MFMA(a, b, c) __builtin_amdgcn_mfma_f32_32x32x16_bf16((a), (b), (c), 0, 0, 0)

constexpr int NB = 4, SEQ = 8192, DM = 1024, CTX = 256, TT = SEQ + CTX, ROWS = NB * TT;
constexpr int IN_COLS = 9424, OFF_DA = 0, OFF_SSD = 1536, OFF_MLA = 3088, OFF_HY = 3792, OFF_GATE = 5328;
constexpr int FFN = 2816;
constexpr float EPS = 1e-6f;
constexpr int NCH = TT / 128;
constexpr int FN = 8192;

enum { I_X = 0, I_C, I_CTX, I_CCTX, I_MODW, I_MODB, I_NMPRE, I_NMPOST, I_NFPRE, I_NFPOST, I_WIN, I_DALAM, I_DASUB,
       I_SCW, I_SCB, I_SALOG, I_SDTB, I_SD, I_SNORM, I_MQN, I_WUQ, I_MKVN, I_WUKV, I_HCW, I_HCB, I_HW1, I_HB1, I_HF1,
       I_HW2, I_HB2, I_HF2, I_HW3, I_HBIAS, I_WBDA, I_WBSSD, I_WBMLA, I_WBHY, I_WOUT, I_W1, I_W3, I_W2, N_IN };

struct Params { const float* in[N_IN]; float* out; unsigned char* ws; };
typedef const __attribute__((address_space(4))) Params* PP;

constexpr size_t MiB = 1048576;
constexpr size_t W_WIN = 0;
constexpr size_t W_UQ = W_WIN + (size_t)9552 * 1024 * 2;
constexpr size_t W_UKV = W_UQ + (size_t)768 * 384 * 2;
constexpr size_t W_BR = W_UKV + (size_t)1024 * 256 * 2;
constexpr size_t W_OUT = W_BR + (size_t)4 * 1024 * 512 * 2;
constexpr size_t W_F1 = W_OUT + (size_t)1024 * 1024 * 2;
constexpr size_t W_F3 = W_F1 + (size_t)2816 * 1024 * 2;
constexpr size_t W_F2 = W_F3 + (size_t)2816 * 1024 * 2;
constexpr size_t W_END = W_F2 + (size_t)2816 * 1024 * 2;
static_assert(W_END <= 43 * MiB, "weights region");
constexpr size_t S_BASE = 43 * MiB;
constexpr size_t S_MOD = S_BASE;
constexpr size_t S_MODP = S_MOD + (size_t)2 * 5 * 6144 * 4;
constexpr size_t S_W2 = S_MODP + (size_t)2 * 16 * 5 * 6144 * 4;
constexpr size_t S_HID = S_W2 + (size_t)8192 * 8;
constexpr size_t S_HIDC = S_HID + (size_t)8192 * 64 * 4;
constexpr size_t S_DT = S_HIDC + (size_t)256 * 64 * 4;
constexpr size_t S_CDEC = S_DT + (size_t)ROWS * 16 * 4;
constexpr size_t S_CTR = S_CDEC + (size_t)2 * NB * NCH * 8 * 4;
constexpr size_t S_XCTX = S_CTR + 256;
constexpr size_t S_BAR = S_XCTX + (size_t)NB * CTX * DM * 4;
constexpr size_t S_END = S_BAR + 16384;
static_assert(S_END <= 57 * MiB, "small region");
constexpr size_t H_OFF = 57 * MiB;
constexpr size_t AR = 123 * MiB;
constexpr size_t A_OHY = AR + 356 * MiB, A_OMLA = AR + 323 * MiB, A_DAQ = AR + 290 * MiB;
constexpr size_t A_PTHY = AR, A_GSPEC = AR + 99 * MiB, A_ZSAVE = AR + 227 * MiB, A_YSAVE = AR + 259 * MiB;
constexpr size_t A_MLAQ = AR, A_DAK = AR + 99 * MiB / 2, A_DAVT = A_DAK + 33 * MiB, A_MLAC = A_DAVT + 33 * MiB;
constexpr size_t A_MLAKN = A_MLAC + 46 * MiB, A_MLAVT = A_MLAKN + 33 * MiB;
static_assert(A_MLAVT + 33 * MiB <= A_DAQ, "round A");
constexpr size_t A_SSDZX = AR, A_STF = AR + 99 * MiB, A_STB = A_STF + 66 * MiB, A_YBUF = A_STB + 66 * MiB;
constexpr size_t A_XSACT = AR + 132 * MiB, A_BCACT = AR + 198 * MiB;
constexpr size_t A_MIXED = AR + 99 * MiB, A_YOUT = A_MIXED + 66 * MiB;
constexpr size_t A_ACT = AR, A_F = AR + 182 * MiB;
constexpr size_t WS_NEED = 512 * MiB;

constexpr int LDS_BYTES = 73728;

DI int get_tid() { int t = threadIdx.x; asm volatile("" : "+v"(t)); return t; }
DI int get_bid() { int t = blockIdx.x; asm volatile("" : "+s"(t)); return t; }
typedef __attribute__((ext_vector_type(2))) __bf16 B2;
DI u16 f2bf(float x) { __bf16 b = (__bf16)x; return __builtin_bit_cast(u16, b); }
DI float bf2f(u16 h) { return __uint_as_float(((unsigned)h) << 16); }
DI unsigned pack2(float a, float b) { F2 v = {a, b}; B2 r = __builtin_convertvector(v, B2); return __builtin_bit_cast(unsigned, r); }
DI float lo2f(unsigned v) { return __uint_as_float(v << 16); }
DI float hi2f(unsigned v) { return __uint_as_float(v & 0xffff0000u); }
DI void unpack8(const U4& v, float (&x)[8]) {
  x[0] = lo2f(v.x); x[1] = hi2f(v.x); x[2] = lo2f(v.y); x[3] = hi2f(v.y);
  x[4] = lo2f(v.z); x[5] = hi2f(v.z); x[6] = lo2f(v.w); x[7] = hi2f(v.w);
}
DI U4 pack8(const float (&x)[8]) { return mku4(pack2(x[0], x[1]), pack2(x[2], x[3]), pack2(x[4], x[5]), pack2(x[6], x[7])); }
DI float wave_sum(float v) { for (int o = 32; o > 0; o >>= 1) v += __shfl_xor(v, o); return v; }
DI float siluf(float x) { return x / (1.f + __expf(-x)); }
DI float sigmoidf(float x) { return 1.f / (1.f + __expf(-x)); }
DI float fexp2(float x) { return __builtin_amdgcn_exp2f(x); }
DI int crow(int t, int h) { return (t & 3) + 8 * (t >> 2) + 4 * h; }
DI f32x16 zero16() { f32x16 z; for (int i = 0; i < 16; ++i) z[i] = 0.f; return z; }

DI const float* xrow_in(PP p, int r, bool first) {
  int b = r / TT, t = r - b * TT;
  if (first) return t < CTX ? p->in[I_CTX] + ((size_t)b * CTX + t) * DM : p->in[I_X] + ((size_t)b * SEQ + (t - CTX)) * DM;
  return t < CTX ? (const float*)(p->ws + S_XCTX) + ((size_t)b * CTX + t) * DM : p->out + ((size_t)b * SEQ + (t - CTX)) * DM;
}
DI float* xrow_out(PP p, int r) {
  int b = r / TT, t = r - b * TT;
  return t < CTX ? (float*)(p->ws + S_XCTX) + ((size_t)b * CTX + t) * DM : p->out + ((size_t)b * SEQ + (t - CTX)) * DM;
}
DI const float* modvec(PP p, int l, int s, int idx) { return (const float*)(p->ws + S_MOD) + ((size_t)(l * 5 + s) * 6 + idx) * DM; }

constexpr int GL = 72;
template <int MT, bool SWAP = true>
DI void gemm_acc(f32x16 (&acc)[MT][2], const u16* __restrict__ A, int lda, const u16* __restrict__ Bt, int ldb, int K, u16* lds) {
  const int tid = get_tid(), lane = tid & 63, w = tid >> 6, wm = w >> 1, wn = w & 1, r = lane & 31, h = lane >> 5;
  constexpr int STG = 256 * GL;
  U4 ra[2 * MT], rb[4];
  const int lrow = tid >> 3, lkc = (tid & 7) * 8;
  const u16* Ap = A + (size_t)lrow * lda + lkc; const u16* Bp = Bt + (size_t)lrow * ldb + lkc;
  const unsigned a32 = 32u * (unsigned)lda, b32 = 32u * (unsigned)ldb;
#pragma unroll
  for (int i = 0; i < 2 * MT; ++i) ra[i] = *(const U4*)(Ap + i * a32);
#pragma unroll
  for (int i = 0; i < 4; ++i) rb[i] = *(const U4*)(Bp + i * b32);
  __syncthreads();
  {
    u16* As = lds; u16* Bs = lds + 128 * GL;
#pragma unroll
    for (int i = 0; i < 2 * MT; ++i) *(U4*)(As + (lrow + 32 * i) * GL + lkc) = ra[i];
#pragma unroll
    for (int i = 0; i < 4; ++i) *(U4*)(Bs + (lrow + 32 * i) * GL + lkc) = rb[i];
  }
  if (K > 64) {
#pragma unroll
    for (int i = 0; i < 2 * MT; ++i) ra[i] = *(const U4*)(Ap + 64 + i * a32);
#pragma unroll
    for (int i = 0; i < 4; ++i) rb[i] = *(const U4*)(Bp + 64 + i * b32);
  }
  __syncthreads();
  const int KT = K >> 6;
  for (int kt = 0; kt < KT; ++kt) {
    const u16* As = lds + (kt & 1) * STG; const u16* Bs = As + 128 * GL;
    if (kt + 1 < KT) {
      u16* An = lds + ((kt + 1) & 1) * STG; u16* Bn = An + 128 * GL;
#pragma unroll
      for (int i = 0; i < 2 * MT; ++i) *(U4*)(An + (lrow + 32 * i) * GL + lkc) = ra[i];
#pragma unroll
      for (int i = 0; i < 4; ++i) *(U4*)(Bn + (lrow + 32 * i) * GL + lkc) = rb[i];
      if (kt + 2 < KT) {
        const int ko = (kt + 2) * 64;
#pragma unroll
        for (int i = 0; i < 2 * MT; ++i) ra[i] = *(const U4*)(Ap + ko + i * a32);
#pragma unroll
        for (int i = 0; i < 4; ++i) rb[i] = *(const U4*)(Bp + ko + i * b32);
      }
    }
#pragma unroll
    for (int ks = 0; ks < 4; ++ks) {
      bf16x8 a[MT], b[2];
#pragma unroll
      for (int i = 0; i < MT; ++i) a[i] = *(const bf16x8*)(As + (wm * 32 * MT + i * 32 + r) * GL + ks * 16 + h * 8);
#pragma unroll
      for (int j = 0; j < 2; ++j) b[j] = *(const bf16x8*)(Bs + (wn * 64 + j * 32 + r) * GL + ks * 16 + h * 8);
#pragma unroll
      for (int i = 0; i < MT; ++i)
#pragma unroll
        for (int j = 0; j < 2; ++j) acc[i][j] = SWAP ? MFMA(b[j], a[i], acc[i][j]) : MFMA(a[i], b[j], acc[i][j]);
    }
    __syncthreads();
  }
}
template <int MT> DI void zero_acc(f32x16 (&acc)[MT][2]) { for (int i = 0; i < MT; ++i) for (int j = 0; j < 2; ++j) acc[i][j] = zero16(); }

template <int MT, int NT>
DI void wave_mma(f32x16 (&acc)[MT][NT], const u16* A, int lda, const u16* Bt, int ldb, int K) {
  const int lane = get_tid() & 63, r = lane & 31, h = lane >> 5;
  for (int k = 0; k < K; k += 16) {
    bf16x8 a[MT], b[NT];
#pragma unroll
    for (int i = 0; i < MT; ++i) a[i] = *(const bf16x8*)(A + (i * 32 + r) * lda + k + h * 8);
#pragma unroll
    for (int j = 0; j < NT; ++j) b[j] = *(const bf16x8*)(Bt + (j * 32 + r) * ldb + k + h * 8);
#pragma unroll
    for (int i = 0; i < MT; ++i)
#pragma unroll
      for (int j = 0; j < NT; ++j) acc[i][j] = MFMA(a[i], b[j], acc[i][j]);
  }
}

template <int MT>
DI void store_tile_bf16(const f32x16 (&acc)[MT][2], u16* dst, size_t ldc, int row0, int col0, int ncols) {
  const int lane = get_tid() & 63, w = get_tid() >> 6, wm = w >> 1, wn = w & 1, r = lane & 31, h = lane >> 5;
#pragma unroll
  for (int i = 0; i < MT; ++i) {
    u16* rowp = dst + (size_t)(row0 + wm * 32 * MT + i * 32 + r) * ldc;
#pragma unroll
    for (int j = 0; j < 2; ++j)
#pragma unroll
      for (int g = 0; g < 4; ++g) {
        int col = col0 + wn * 64 + j * 32 + 8 * g + 4 * h;
        if (col < ncols) *(U2*)(rowp + col) = mku2(pack2(acc[i][j][4 * g], acc[i][j][4 * g + 1]), pack2(acc[i][j][4 * g + 2], acc[i][j][4 * g + 3]));
      }
  }
}
DI void store_tile_f32(const f32x16 (&acc)[2][2], float* dst, size_t ldc, int row0, int col0, int ncols) {
  const int lane = get_tid() & 63, w = get_tid() >> 6, wm = w >> 1, wn = w & 1, r = lane & 31, h = lane >> 5;
#pragma unroll
  for (int i = 0; i < 2; ++i) {
    float* rowp = dst + (size_t)(row0 + wm * 64 + i * 32 + r) * ldc;
#pragma unroll
    for (int j = 0; j < 2; ++j)
#pragma unroll
      for (int g = 0; g < 4; ++g) {
        int col = col0 + wn * 64 + j * 32 + 8 * g + 4 * h;
        if (col < ncols) *(F4*)(rowp + col) = mkf4(acc[i][j][4 * g], acc[i][j][4 * g + 1], acc[i][j][4 * g + 2], acc[i][j][4 * g + 3]);
      }
  }
}
DI void store_tile_T(const f32x16 (&acc)[2][2], u16* dstT, int ncolsT, int row0, int col0) {
  const int lane = get_tid() & 63, w = get_tid() >> 6, wm = w >> 1, wn = w & 1, r = lane & 31, h = lane >> 5;
  const int b = row0 / TT, t0 = row0 - b * TT;
#pragma unroll
  for (int i = 0; i < 2; ++i)
#pragma unroll
    for (int j = 0; j < 2; ++j) {
      int col = col0 + wn * 64 + j * 32 + r;
      u16* base = dstT + ((size_t)b * ncolsT + col) * TT + t0 + wm * 64 + i * 32 + 4 * h;
#pragma unroll
      for (int g = 0; g < 4; ++g) {
        U2 v = mku2(pack2(acc[i][j][4 * g], acc[i][j][4 * g + 1]), pack2(acc[i][j][4 * g + 2], acc[i][j][4 * g + 3]));
        *(U2*)(base + 8 * g) = v;
      }
    }
}

struct TileIter { int off; };
#define FOR_TILES(IT, NT_, VAR) for (int VAR = (int)(((long)get_bid() - (IT).off % (int)gridDim.x + gridDim.x) % gridDim.x); VAR < (NT_); VAR += gridDim.x)

DI void conv_job(TileIter& it, const float* src, int K, int N, u16* dst, float* tile  ) {
  const int tid = get_tid();
  const int nkt = K / 64, nnt = (N + 63) / 64, ntile = nkt * nnt;
  FOR_TILES(it, ntile, ti) {
    int kt = ti % nkt, nt = ti / nkt;
    __syncthreads();
#pragma unroll
    for (int i = 0; i < 4; ++i) {
      int kr = (tid >> 4) + 16 * i, nc = (tid & 15) * 4;
      int n = nt * 64 + nc;
      F4 v = mkf4(0.f, 0.f, 0.f, 0.f);
      if (n < N) v = *(const F4*)(src + (size_t)(kt * 64 + kr) * N + n);
      tile[kr * 65 + nc] = v.x; tile[kr * 65 + nc + 1] = v.y; tile[kr * 65 + nc + 2] = v.z; tile[kr * 65 + nc + 3] = v.w;
    }
    __syncthreads();
    int nl = tid >> 2, kc = (tid & 3) * 16;
    int n = nt * 64 + nl;
    if (n < N) {
      float x[8];
#pragma unroll
      for (int hlf = 0; hlf < 2; ++hlf) {
#pragma unroll
        for (int e = 0; e < 8; ++e) x[e] = tile[(kc + hlf * 8 + e) * 65 + nl];
        *(U4*)(dst + (size_t)n * K + kt * 64 + kc + hlf * 8) = pack8(x);
      }
    }
  }
  it.off += ntile;
}

DI void phase_conv(PP p, int l, unsigned char* lds) {
  float* tile = (float*)lds;
  unsigned char* ws = p->ws;
  TileIter it{0};
  conv_job(it, p->in[I_WIN] + (size_t)l * DM * IN_COLS, DM, IN_COLS, (u16*)(ws + W_WIN), tile);
  conv_job(it, p->in[I_WUQ] + (size_t)l * 384 * 768, 384, 768, (u16*)(ws + W_UQ), tile);
  conv_job(it, p->in[I_WUKV] + (size_t)l * 256 * 1024, 256, 1024, (u16*)(ws + W_UKV), tile);
  for (int i = 0; i < 4; ++i) conv_job(it, p->in[I_WBDA + i] + (size_t)l * 512 * 1024, 512, 1024, (u16*)(ws + W_BR) + (size_t)i * 1024 * 512, tile);
  conv_job(it, p->in[I_WOUT] + (size_t)l * DM * DM, DM, DM, (u16*)(ws + W_OUT), tile);
  conv_job(it, p->in[I_W1] + (size_t)l * DM * FFN, DM, FFN, (u16*)(ws + W_F1), tile);
  conv_job(it, p->in[I_W3] + (size_t)l * DM * FFN, DM, FFN, (u16*)(ws + W_F3), tile);
  conv_job(it, p->in[I_W2] + (size_t)l * FFN * DM, FFN, DM, (u16*)(ws + W_F2), tile);
  const int tid = get_tid();
  if (get_bid() == 0 && tid < 64) ((int*)(ws + S_CTR))[tid] = 0;
  if (l == 0) {
    F2* W2 = (F2*)(ws + S_W2);
    for (int m = get_bid() * 256 + tid; m < 8192; m += gridDim.x * 256) {
      float sn, cs; sincospif((float)m * (1.f / 8192.f), &sn, &cs);
      W2[m] = mkf2(cs, -sn);
    }
    float* modp = (float*)(ws + S_MODP);
    for (int itx = get_bid(); itx < 2 * 24 * 16; itx += gridDim.x) {
      int l2 = itx / 384, rem = itx % 384, cb = rem / 16, ks = rem % 16;
      int col = cb * 256 + tid;
      const float* mw = p->in[I_MODW] + (size_t)l2 * DM * 6144;
      float acc[5] = {0.f, 0.f, 0.f, 0.f, 0.f};
#pragma unroll 4
      for (int k = ks * 64; k < ks * 64 + 64; ++k) {
        float wv = mw[(size_t)k * 6144 + col];
#pragma unroll
        for (int s = 0; s < 5; ++s) { float cv = (s < 4) ? p->in[I_C][s * DM + k] : p->in[I_CCTX][k]; acc[s] += siluf(cv) * wv; }
      }
#pragma unroll
      for (int s = 0; s < 5; ++s) modp[(((size_t)l2 * 16 + ks) * 5 + s) * 6144 + col] = acc[s];
    }
  }
  {
    __syncthreads();
    float* feats = (float*)lds;
    float* h1 = feats + 4 * 36;
    const float* w1 = p->in[I_HW1] + (size_t)l * 33 * 64; const float* b1 = p->in[I_HB1] + l * 64; const float* f1 = p->in[I_HF1] + l * 64;
    const float* w2 = p->in[I_HW2] + (size_t)l * 64 * 64; const float* b2 = p->in[I_HB2] + l * 64; const float* f2 = p->in[I_HF2] + l * 64;
    const int nitem = 2048 + (l == 0 ? 64 : 0);
    for (int itx = get_bid(); itx < nitem; itx += gridDim.x) {
      const bool isc = itx >= 2048;
      const int n = isc ? 256 : 8192;
      const int tl = tid >> 6, j = tid & 63;
      const int t = (isc ? (itx - 2048) : itx) * 4 + tl;
      __syncthreads();
      if (j < 33) {
        float f;
        if (j == 0) f = (float)t / (float)(n - 1);
        else {
          int bi = (j - 1) & 15;
          float band = 1e-4f + (float)bi * ((15.0f - 1e-4f) / 15.0f);
          float xx = 2.f * ((float)t / (float)n) * band;
          float sn, cs; sincospif(xx, &sn, &cs);
          f = (j <= 16) ? cs : -sn;
        }
        feats[tl * 36 + j] = f;
      }
      __syncthreads();
      float a = b1[j];
#pragma unroll 3
      for (int i = 0; i < 33; ++i) a += feats[tl * 36 + i] * w1[i * 64 + j];
      h1[tl * 64 + j] = sinf(f1[j] * a);
      __syncthreads();
      float a2 = b2[j];
#pragma unroll 4
      for (int k = 0; k < 64; ++k) a2 += h1[tl * 64 + k] * w2[k * 64 + j];
      const float hv2 = sinf(f2[j] * a2);
      if (isc) ((float*)(ws + S_HIDC))[(size_t)t * 64 + j] = hv2; else ((u16*)(ws + S_HID))[(size_t)t * 64 + j] = f2bf(hv2);
    }
  }
}

DI void phase_modfin(PP p) {
  float* mod = (float*)(p->ws + S_MOD); const float* modp = (const float*)(p->ws + S_MODP);
  for (int i = get_bid() * 256 + get_tid(); i < 2 * 5 * 6144; i += gridDim.x * 256) {
    int l2 = i / (5 * 6144), rem = i % (5 * 6144), s = rem / 6144, col = rem % 6144;
    float a = p->in[I_MODB][l2 * 6144 + col];
#pragma unroll 4
    for (int ks = 0; ks < 16; ++ks) a += modp[(((size_t)l2 * 16 + ks) * 5 + s) * 6144 + col];
    mod[((size_t)(l2 * 5 + s)) * 6144 + col] = a;
  }
}

DI void phase_rowwise(PP p, bool first, const u16* src, const float* g_post, int l_res, int gate_idx,
                      bool write_h, const float* g_pre, int l_mod, int shift_idx, int scale_idx, bool skip_ctx) {
  const int lane = get_tid() & 63, w = get_tid() >> 6;
  u16* H = (u16*)(p->ws + H_OFF);
  for (int r = get_bid() * 4 + w; r < ROWS; r += gridDim.x * 4) {
    int b = r / TT, t = r - b * TT;
    if (skip_ctx && t < CTX) continue;
    int s = t < CTX ? 4 : b;
    const float* xin = xrow_in(p, r, first);
    float x[16];
#pragma unroll
    for (int i = 0; i < 4; ++i) { F4 v = *(const F4*)(xin + i * 256 + lane * 4); x[4 * i] = v.x; x[4 * i + 1] = v.y; x[4 * i + 2] = v.z; x[4 * i + 3] = v.w; }
    if (src) {
      float y[16]; float ss = 0.f;
#pragma unroll
      for (int i = 0; i < 4; ++i) { U2 v = *(const U2*)(src + (size_t)r * DM + i * 256 + lane * 4);
        y[4 * i] = lo2f(v.x); y[4 * i + 1] = hi2f(v.x); y[4 * i + 2] = lo2f(v.y); y[4 * i + 3] = hi2f(v.y); }
#pragma unroll
      for (int i = 0; i < 16; ++i) ss += y[i] * y[i];
      ss = wave_sum(ss);
      float rstd = rsqrtf(ss * (1.f / DM) + EPS);
      const float* gate = modvec(p, l_res, s, gate_idx);
      float* xo = xrow_out(p, r);
#pragma unroll
      for (int i = 0; i < 4; ++i) {
        int k = i * 256 + lane * 4;
        F4 g = *(const F4*)(g_post + k); F4 gt = *(const F4*)(gate + k);
        x[4 * i] += gt.x * (y[4 * i] * rstd * g.x); x[4 * i + 1] += gt.y * (y[4 * i + 1] * rstd * g.y);
        x[4 * i + 2] += gt.z * (y[4 * i + 2] * rstd * g.z); x[4 * i + 3] += gt.w * (y[4 * i + 3] * rstd * g.w);
        *(F4*)(xo + k) = mkf4(x[4 * i], x[4 * i + 1], x[4 * i + 2], x[4 * i + 3]);
      }
    }
    if (write_h) {
      float ss = 0.f;
#pragma unroll
      for (int i = 0; i < 16; ++i) ss += x[i] * x[i];
      ss = wave_sum(ss);
      float rstd = rsqrtf(ss * (1.f / DM) + EPS);
      const float* sh = modvec(p, l_mod, s, shift_idx); const float* sc = modvec(p, l_mod, s, scale_idx);
#pragma unroll
      for (int i = 0; i < 4; ++i) {
        int k = i * 256 + lane * 4;
        F4 g = *(const F4*)(g_pre + k); F4 a = *(const F4*)(sh + k); F4 c = *(const F4*)(sc + k);
        float h0 = x[4 * i] * rstd * g.x * (1.f + c.x) + a.x, h1 = x[4 * i + 1] * rstd * g.y * (1.f + c.y) + a.y;
        float h2 = x[4 * i + 2] * rstd * g.z * (1.f + c.z) + a.z, h3 = x[4 * i + 3] * rstd * g.w * (1.f + c.w) + a.w;
        *(U2*)(H + (size_t)r * DM + k) = mku2(pack2(h0, h1), pack2(h2, h3));
      }
    }
  }
}

DI void gemm_job(TileIter& it, const u16* A, int lda, const u16* Bt, int ldb, int K, int N, int mode, void* dst, int ldc, u16* lds, bool skipc = false) {
  const int ntn = (N + 127) / 128, ntile = (skipc ? NB * 64 : ROWS / 128) * ntn;
  FOR_TILES(it, ntile, ti) {
    int tm = ti / ntn, tn = ti % ntn;
    if (skipc) tm = NCH * (tm >> 6) + 2 + (tm & 63);
    f32x16 acc[2][2]; zero_acc<2>(acc);
    if (mode == 2) {
      gemm_acc<2, false>(acc, A + (size_t)tm * 128 * lda, lda, Bt + (size_t)tn * 128 * ldb, ldb, K, lds);
      store_tile_T(acc, (u16*)dst, N, tm * 128, tn * 128);
    } else {
      gemm_acc<2, true>(acc, A + (size_t)tm * 128 * lda, lda, Bt + (size_t)tn * 128 * ldb, ldb, K, lds);
      if (mode == 0) store_tile_bf16<2>(acc, (u16*)dst, ldc, tm * 128, tn * 128, N);
      else store_tile_f32(acc, (float*)dst, ldc, tm * 128, tn * 128, N);
    }
  }
  it.off += ntile;
}

DI void phase_rope(PP p, int l) {
  const int lane = get_tid() & 63, w = get_tid() >> 6;
  u16* daq = (u16*)(p->ws + A_DAQ); u16* dak = (u16*)(p->ws + A_DAK); u16* mc = (u16*)(p->ws + A_MLAC);
  const float* qn = p->in[I_MQN] + l * 384; const float* kvn = p->in[I_MKVN] + l * 256;
  const float L2_10000 = 13.287712379549449f;
  for (int r = get_bid() * 4 + w; r < ROWS; r += gridDim.x * 4) {
    int b = r / TT, t = r - b * TT;
    const bool lat = t >= CTX;
    const int pos = t - CTX; const float prow = (float)(pos >> 6), pcol = (float)(pos & 63);
    if (lat) {
      int v = lane >> 3, i0 = (lane & 7) * 4;
      float cs[4], sn[4];
#pragma unroll
      for (int e = 0; e < 4; ++e) { int i = i0 + e; float inv = exp2f(-(float)(i & 15) * (1.f / 16.f) * L2_10000); float rv = (i < 16 ? prow : pcol) * inv * 0.15915494309189535f; sn[e] = __builtin_amdgcn_sinf(rv); cs[e] = __builtin_amdgcn_cosf(rv); }
#pragma unroll
      for (int which = 0; which < 2; ++which) {
        u16* base = (which ? dak : daq) + (size_t)r * 512 + v * 64 + i0;
        U2 a = *(U2*)base, c = *(U2*)(base + 32);
        float x1[4] = {lo2f(a.x), hi2f(a.x), lo2f(a.y), hi2f(a.y)}, x2[4] = {lo2f(c.x), hi2f(c.x), lo2f(c.y), hi2f(c.y)};
        float o1[4], o2[4];
#pragma unroll
        for (int e = 0; e < 4; ++e) { o1[e] = x1[e] * cs[e] - x2[e] * sn[e]; o2[e] = x2[e] * cs[e] + x1[e] * sn[e]; }
        *(U2*)base = mku2(pack2(o1[0], o1[1]), pack2(o1[2], o1[3]));
        *(U2*)(base + 32) = mku2(pack2(o2[0], o2[1]), pack2(o2[2], o2[3]));
      }
    }
    u16* row = mc + (size_t)r * 704;
    {
      float x[6]; float ss = 0.f;
#pragma unroll
      for (int i = 0; i < 3; ++i) { unsigned v = *(unsigned*)(row + i * 128 + lane * 2); x[2 * i] = lo2f(v); x[2 * i + 1] = hi2f(v); }
#pragma unroll
      for (int i = 0; i < 6; ++i) ss += x[i] * x[i];
      ss = wave_sum(ss); float rstd = rsqrtf(ss * (1.f / 384.f) + EPS);
#pragma unroll
      for (int i = 0; i < 3; ++i) { int k = i * 128 + lane * 2; *(unsigned*)(row + k) = pack2(x[2 * i] * rstd * qn[k], x[2 * i + 1] * rstd * qn[k + 1]); }
    }
    {
      float x[4]; float ss = 0.f;
#pragma unroll
      for (int i = 0; i < 2; ++i) { unsigned v = *(unsigned*)(row + 384 + i * 128 + lane * 2); x[2 * i] = lo2f(v); x[2 * i + 1] = hi2f(v); }
#pragma unroll
      for (int i = 0; i < 4; ++i) ss += x[i] * x[i];
      ss = wave_sum(ss); float rstd = rsqrtf(ss * (1.f / 256.f) + EPS);
#pragma unroll
      for (int i = 0; i < 2; ++i) { int k = i * 128 + lane * 2; *(unsigned*)(row + 384 + k) = pack2(x[2 * i] * rstd * kvn[k], x[2 * i + 1] * rstd * kvn[k + 1]); }
    }
    if (lat && lane < 32) {
      int i = lane; float inv = exp2f(-(float)(i & 15) * (1.f / 16.f) * L2_10000); float rv = (i < 16 ? prow : pcol) * inv * 0.15915494309189535f; float sn = __builtin_amdgcn_sinf(rv), cs = __builtin_amdgcn_cosf(rv);
      float x1 = bf2f(row[640 + i]), x2 = bf2f(row[640 + 32 + i]);
      row[640 + i] = f2bf(x1 * cs - x2 * sn); row[640 + 32 + i] = f2bf(x2 * cs + x1 * sn);
    }
  }
}

template <int DQK>
struct AttnState { f32x16 ot[4]; float m, l; };

template <int DQK, int QR>
DI void attn_tile(AttnState<DQK>& st, const bf16x8 (&q)[QR], const u16* qlds, const u16* Ks, int kcol0, const u16* Vs) {
  constexpr int KL = (DQK == 64 ? 128 : 192) + 8;
  const int lane = get_tid() & 63, r = lane & 31, h = lane >> 5;
#pragma unroll
  for (int kb = 0; kb < 2; ++kb) {
    f32x16 s = zero16();
#pragma unroll
    for (int ks = 0; ks < DQK / 16; ++ks) {
      bf16x8 a = *(const bf16x8*)(Ks + (kb * 32 + r) * KL + kcol0 + ks * 16 + h * 8);
      bf16x8 qv;
      if (ks < QR) qv = q[ks < QR ? ks : 0]; else qv = *(const bf16x8*)(qlds + (ks - QR) * 16);
      s = MFMA(a, qv, s);
    }
    if (DQK == 192) __builtin_amdgcn_sched_barrier(0);
    float mx = s[0];
#pragma unroll
    for (int t = 1; t < 16; ++t) mx = fmaxf(mx, s[t]);
    mx = fmaxf(mx, __shfl_xor(mx, 32));
    const float mnew = fmaxf(st.m, mx);
    const float alpha = fexp2(st.m - mnew);
    st.m = mnew;
    float ps = 0.f;
#pragma unroll
    for (int t = 0; t < 16; ++t) { float pv = fexp2(s[t] - mnew); s[t] = pv; ps += pv; }
    st.l = st.l * alpha + ps;
    if (__builtin_amdgcn_ballot_w64(alpha != 1.f) != 0) {
#pragma unroll
      for (int eb = 0; eb < 4; ++eb)
#pragma unroll
        for (int t = 0; t < 16; ++t) st.ot[eb][t] *= alpha;
    }
#pragma unroll
    for (int s2 = 0; s2 < 2; ++s2) {
      unsigned pk[4];
#pragma unroll
      for (int j = 0; j < 4; ++j) pk[j] = pack2(s[8 * s2 + 2 * j], s[8 * s2 + 2 * j + 1]);
      bf16x8 pf = __builtin_bit_cast(bf16x8, mku4(pk[0], pk[1], pk[2], pk[3]));
#pragma unroll
      for (int eb = 0; eb < 4; ++eb) {
        const u16* vp = Vs + (eb * 32 + r) * 72 + kb * 32 + 16 * s2 + 4 * h;
        U2 lo = *(const U2*)vp, hi = *(const U2*)(vp + 8);
        bf16x8 vf = __builtin_bit_cast(bf16x8, mku4(lo.x, lo.y, hi.x, hi.y));
        st.ot[eb] = MFMA(vf, pf, st.ot[eb]);
      }
    }
    if (DQK == 192) __builtin_amdgcn_sched_barrier(0);
  }
}

DI void phase_attn(PP p, int l, bool need_ctx, unsigned char* ldsb, int probe = 0) {
  const int tid = get_tid(), lane = tid & 63, w = tid >> 6, r = lane & 31, h = lane >> 5;
  unsigned char* ws = p->ws;
  const u16* mlaq = (const u16*)(ws + A_MLAQ); const u16* mlakn = (const u16*)(ws + A_MLAKN); const u16* mlavt = (const u16*)(ws + A_MLAVT);
  const u16* mlac = (const u16*)(ws + A_MLAC); u16* omla = (u16*)(ws + A_OMLA);
  u16* daq = (u16*)(ws + A_DAQ); const u16* dak = (const u16*)(ws + A_DAK); const u16* davt = (const u16*)(ws + A_DAVT);
  const float L2E = 1.4426950408889634f, L2_10000 = 13.287712379549449f;
  const int n_mla = NB * 66 * 4, n_da = NB * 132 * 4;
  int* ctr = (int*)(ws + S_CTR);
  int* sh_item = (int*)(ldsb + 72704);
  const int grp = get_bid() & 7;
  const int n_items = probe ? 128 : 384 + (need_ctx ? 12 : 0);
  for (;;) {
    __syncthreads();
    if (tid == 0) *sh_item = atomicAdd(ctr + grp + (probe ? 8 : 0), 1);
    __syncthreads();
    const int qi = *sh_item;
    if (qi >= n_items) break;
    int item;
    if (qi < 128) { int pr = grp + 8 * (qi >> 6), qb = 2 + (qi & 63); item = (pr >> 2) * 264 + qb * 4 + (pr & 3); }
    else if (qi < 384) { int q2 = qi - 128; int pr = grp + 8 * (q2 >> 7), qb = 4 + (q2 & 127); item = n_mla + (pr >> 2) * 528 + qb * 4 + (pr & 3); }
    else if (qi < 388) { int q2 = qi - 384; int pr = grp + 8 * (q2 >> 1), qb = q2 & 1; item = (pr >> 2) * 264 + qb * 4 + (pr & 3); }
    else { int q2 = qi - 388; int pr = grp + 8 * (q2 >> 2), qb = q2 & 3; item = n_mla + (pr >> 2) * 528 + qb * 4 + (pr & 3); }
    if (item < n_mla) {
      const int b = item / 264, rem = item % 264, qb = rem >> 2, hd = rem & 3;
      const int nk = qb < 2 ? CTX : TT;
      constexpr int KL = 200;
      u16* Ks = (u16*)ldsb; u16* Vs = Ks + 64 * KL;
      const int tq = qb * 128 + w * 32 + r; const size_t qrow = (size_t)b * TT + tq;
      bf16x8 q[12];
      const u16* qlds = nullptr;
      {
        const float sc = 0.07216878364870323f * L2E;
        const u16* qp = mlaq + qrow * 768 + hd * 192 + h * 8;
#pragma unroll
        for (int ks = 0; ks < 8; ++ks) { U4 v = *(const U4*)(qp + ks * 16); float tmp[8]; unpack8(v, tmp);
#pragma unroll
          for (int j = 0; j < 8; ++j) tmp[j] *= sc;
          q[ks] = __builtin_bit_cast(bf16x8, pack8(tmp)); }
        const bool lat = tq >= CTX;
        const int pos = tq - CTX; const float prow = (float)(pos >> 6), pcol = (float)(pos & 63);
#pragma unroll
        for (int ks = 8; ks < 10; ++ks) {
          U4 v1 = *(const U4*)(qp + ks * 16), v2 = *(const U4*)(qp + (ks + 2) * 16); float x1[8], x2[8]; unpack8(v1, x1); unpack8(v2, x2);
#pragma unroll
          for (int j = 0; j < 8; ++j) {
            int i = (ks - 8) * 16 + h * 8 + j; float inv = exp2f(-(float)(i & 15) * (1.f / 16.f) * L2_10000); float ang = (i < 16 ? prow : pcol) * inv;
            float sn = lat ? __sinf(ang) : 0.f, cs = lat ? __cosf(ang) : 1.f;
            float a = x1[j], c2 = x2[j]; x1[j] = (a * cs - c2 * sn) * sc; x2[j] = (c2 * cs + a * sn) * sc;
          }
          q[ks] = __builtin_bit_cast(bf16x8, pack8(x1)); q[ks + 2] = __builtin_bit_cast(bf16x8, pack8(x2));
        }
      }
      AttnState<192> st; for (int eb = 0; eb < 4; ++eb) st.ot[eb] = zero16(); st.m = -1e30f; st.l = 0.f;
      U4 rk[6], rv[4];
      const u16* kbase = mlakn + ((size_t)b * TT) * 512 + hd * 128; const unsigned koff0 = (unsigned)((tid >> 4) * 512 + (tid & 15) * 8);
      const u16* rbase = mlac + ((size_t)b * TT) * 704 + 640; const unsigned roff0 = (unsigned)((tid >> 3) * 704 + (tid & 7) * 8);
      const u16* vbase = mlavt + ((size_t)b * 512 + hd * 128) * TT; const unsigned voff0 = (unsigned)((tid >> 3) * TT + (tid & 7) * 8);
      auto gl = [&](int k0) {
#pragma unroll
        for (int i = 0; i < 4; ++i) rk[i] = *(const U4*)(kbase + (koff0 + (unsigned)((k0 + 16 * i) * 512)));
#pragma unroll
        for (int i = 0; i < 2; ++i) rk[4 + i] = *(const U4*)(rbase + (roff0 + (unsigned)((k0 + 32 * i) * 704)));
#pragma unroll
        for (int i = 0; i < 4; ++i) rv[i] = *(const U4*)(vbase + (voff0 + (unsigned)(32 * i * TT + k0)));
      };
      for (int k0 = 0; k0 < nk; k0 += 64) {
        gl(k0);
        __syncthreads();
#pragma unroll
        for (int i = 0; i < 4; ++i) { int c = tid + 256 * i, key = c >> 4, kc = c & 15; *(U4*)(Ks + key * KL + kc * 8) = rk[i]; }
#pragma unroll
        for (int i = 0; i < 2; ++i) { int c = tid + 256 * i, key = c >> 3, kc = c & 7; *(U4*)(Ks + key * KL + 128 + kc * 8) = rk[4 + i]; }
#pragma unroll
        for (int i = 0; i < 4; ++i) { int c = tid + 256 * i, e = c >> 3, kc = c & 7; *(U4*)(Vs + e * 72 + kc * 8) = rv[i]; }
        __syncthreads();
        attn_tile<192, 12>(st, q, qlds, Ks, 0, Vs);
      }
      float lt = st.l + __shfl_xor(st.l, 32); float il = 1.f / lt;
#pragma unroll
      for (int eb = 0; eb < 4; ++eb)
#pragma unroll
        for (int g = 0; g < 4; ++g) {
          U2 v = mku2(pack2(st.ot[eb][4 * g] * il, st.ot[eb][4 * g + 1] * il), pack2(st.ot[eb][4 * g + 2] * il, st.ot[eb][4 * g + 3] * il));
          *(U2*)(omla + qrow * 512 + hd * 128 + eb * 32 + 8 * g + 4 * h) = v;
        }
    } else {
      const int it2 = item - n_mla;
      const int b = it2 / 528, rem = it2 % 528, qb = rem >> 2, hd = rem & 3;
      const int nk = qb < 4 ? CTX : TT;
      constexpr int KL = 136;
      u16* Ks = (u16*)ldsb; u16* Vs = Ks + 64 * KL;
      const int comp = w >> 1;
      const int tq = qb * 64 + (w & 1) * 32 + r; const size_t qrow = (size_t)b * TT + tq;
      bf16x8 q[4];
      {
        const float sc = 0.125f * L2E;
#pragma unroll
        for (int ks = 0; ks < 4; ++ks) { U4 v = *(const U4*)(daq + qrow * 512 + hd * 128 + comp * 64 + ks * 16 + h * 8); float tmp[8]; unpack8(v, tmp);
#pragma unroll
          for (int j = 0; j < 8; ++j) tmp[j] *= sc;
          q[ks] = __builtin_bit_cast(bf16x8, pack8(tmp)); }
      }
      AttnState<64> st; for (int eb = 0; eb < 4; ++eb) st.ot[eb] = zero16(); st.m = -1e30f; st.l = 0.f;
      U4 rk[4], rv[4];
      const u16* kbase = dak + ((size_t)b * TT) * 512 + hd * 128; const unsigned koff0 = (unsigned)((tid >> 4) * 512 + (tid & 15) * 8);
      const u16* vbase = davt + ((size_t)b * 512 + hd * 128) * TT; const unsigned voff0 = (unsigned)((tid >> 3) * TT + (tid & 7) * 8);
      auto gl = [&](int k0) {
#pragma unroll
        for (int i = 0; i < 4; ++i) rk[i] = *(const U4*)(kbase + (koff0 + (unsigned)((k0 + 16 * i) * 512)));
#pragma unroll
        for (int i = 0; i < 4; ++i) rv[i] = *(const U4*)(vbase + (voff0 + (unsigned)(32 * i * TT + k0)));
      };
      gl(0);
      for (int k0 = 0; k0 < nk; k0 += 64) {
        __syncthreads();
#pragma unroll
        for (int i = 0; i < 4; ++i) { int c = tid + 256 * i, key = c >> 4, kc = c & 15; *(U4*)(Ks + key * KL + kc * 8) = rk[i]; }
#pragma unroll
        for (int i = 0; i < 4; ++i) { int c = tid + 256 * i, e = c >> 3, kc = c & 7; *(U4*)(Vs + e * 72 + kc * 8) = rv[i]; }
        __syncthreads();
        if (k0 + 64 < nk) gl(k0 + 64);
        attn_tile<64, 4>(st, q, nullptr, Ks, comp * 64, Vs);
      }
      float lt = st.l + __shfl_xor(st.l, 32); float il = 1.f / lt;
      __syncthreads();
      float* O2 = (float*)ldsb;
      const int ql = (w & 1) * 32 + r;
      if (comp == 1) {
#pragma unroll
        for (int eb = 0; eb < 4; ++eb)
#pragma unroll
          for (int t = 0; t < 16; ++t) O2[ql * 132 + eb * 32 + crow(t, h)] = st.ot[eb][t] * il;
      }
      __syncthreads();
      if (comp == 0) {
        const float* lv = p->in[I_DALAM] + l * 256;
        float d1 = 0.f, d2 = 0.f;
#pragma unroll 4
        for (int i = 0; i < 64; ++i) { d1 += lv[i] * lv[64 + i]; d2 += lv[128 + i] * lv[192 + i]; }
        const float lam_init = 0.8f - 0.6f * expf(-0.3f * (float)l);
        const float lam = expf(d1) - expf(d2) + lam_init;
        float ss = 0.f;
#pragma unroll
        for (int eb = 0; eb < 4; ++eb)
#pragma unroll
          for (int t = 0; t < 16; ++t) { float o = st.ot[eb][t] * il - lam * O2[ql * 132 + eb * 32 + crow(t, h)]; st.ot[eb][t] = o; ss += o * o; }
        ss += __shfl_xor(ss, 32);
        const float rs = rsqrtf(ss * (1.f / 128.f) + EPS) * (1.f - lam_init);
        const float* sub = p->in[I_DASUB] + l * 128;
#pragma unroll
        for (int eb = 0; eb < 4; ++eb)
#pragma unroll
          for (int g = 0; g < 4; ++g) {
            int e = eb * 32 + 8 * g + 4 * h;
            U2 v = mku2(pack2(st.ot[eb][4 * g] * rs * sub[e], st.ot[eb][4 * g + 1] * rs * sub[e + 1]),
                                 pack2(st.ot[eb][4 * g + 2] * rs * sub[e + 2], st.ot[eb][4 * g + 3] * rs * sub[e + 3]));
            *(U2*)(daq + qrow * 512 + hd * 128 + e) = v;
          }
      }
    }
  }
}

constexpr int SL = 136;
DI void ssd_conv8(const u16* zx, int row, int lo, int hi, int ch0, const float* cw, const float* cb, float (&out)[8]) {
  F4 b0 = *(const F4*)(cb + ch0), b1 = *(const F4*)(cb + ch0 + 4);
  float acc[8] = {b0.x, b0.y, b0.z, b0.w, b1.x, b1.y, b1.z, b1.w};
#pragma unroll
  for (int k = 0; k < 5; ++k) {
    int rr = row + k - 2;
    if (rr >= lo && rr < hi) {
      U4 v = *(const U4*)(zx + (size_t)rr * 1536 + 512 + ch0); float x[8]; unpack8(v, x);
      F4 w0 = *(const F4*)(cw + k * 1024 + ch0), w1 = *(const F4*)(cw + k * 1024 + ch0 + 4);
      acc[0] += w0.x * x[0]; acc[1] += w0.y * x[1]; acc[2] += w0.z * x[2]; acc[3] += w0.w * x[3];
      acc[4] += w1.x * x[4]; acc[5] += w1.y * x[5]; acc[6] += w1.z * x[6]; acc[7] += w1.w * x[7];
    }
  }
#pragma unroll
  for (int e = 0; e < 8; ++e) out[e] = siluf(acc[e]);
}
DI float softplusf(float x) { return x > 20.f ? x : log1pf(__expf(x)); }
DI float wave_incl_scan(float v) {
  const int lane = get_tid() & 63;
  for (int o = 1; o < 64; o <<= 1) { float u = __shfl_up(v, o); if (lane >= o) v += u; }
  return v;
}

DI void phase_ssdconv(PP p, int l) {
  const u16* zx = (const u16*)(p->ws + A_SSDZX);
  u16* xs = (u16*)(p->ws + A_XSACT); u16* bc = (u16*)(p->ws + A_BCACT);
  const float* cw = p->in[I_SCW] + (size_t)l * 5 * 1024; const float* cb = p->in[I_SCB] + l * 1024;
  const int total = ROWS * 128;
  for (int i = get_bid() * 256 + get_tid(); i < total; i += gridDim.x * 256) {
    const int row = i >> 7, ch0 = (i & 127) * 8;
    const int b = row / TT, t = row - b * TT;
    const int lo = t < CTX ? b * TT : b * TT + CTX, hi = t < CTX ? b * TT + CTX : (b + 1) * TT;
    float v[8];
    ssd_conv8(zx, row, lo, hi, ch0, cw, cb, v);
    u16* dst = ch0 < 512 ? xs + (size_t)row * 512 + ch0 : bc + (size_t)row * 512 + (ch0 - 512);
    *(U4*)dst = pack8(v);
  }
}
DI void ssd_act8(const u16* base, int row, int col, float (&out)[8]) { U4 v = *(const U4*)(base + (size_t)row * 512 + col); unpack8(v, out); }

DI void phase_ssd1(PP p, int l, unsigned char* ldsb) {
  const int tid = get_tid(), lane = tid & 63, w = tid >> 6, r = lane & 31, h = lane >> 5;
  const u16* xsact = (const u16*)(p->ws + A_XSACT); const u16* bcact = (const u16*)(p->ws + A_BCACT); const float* dtraw = (const float*)(p->ws + S_DT);
  float* cdec = (float*)(p->ws + S_CDEC);
  const float* cw = p->in[I_SCW] + (size_t)l * 5 * 1024; const float* cb = p->in[I_SCB] + l * 1024;
  u16* BT = (u16*)ldsb; u16* xT = BT + 128 * SL; float* wts = (float*)(xT + 64 * SL);
  for (int item = get_bid(); item < NB * NCH * 8; item += gridDim.x) {
    const int b = item / (NCH * 8), rem = item % (NCH * 8), c = rem >> 3, head = rem & 7, g = head >> 2;
    const int rows0 = b * TT + c * 128;
    const int lo = c < 2 ? b * TT : b * TT + CTX, hi = c < 2 ? b * TT + CTX : (b + 1) * TT;
    __syncthreads();
    if (w < 2) {
      const int dir = w;
      const float bias = p->in[I_SDTB][l * 16 + dir * 8 + head]; const float Ah = -__expf(p->in[I_SALOG][l * 16 + dir * 8 + head]);
      float d0 = softplusf(dtraw[(size_t)(rows0 + 2 * lane) * 16 + dir * 8 + head] + bias);
      float d1 = softplusf(dtraw[(size_t)(rows0 + 2 * lane + 1) * 16 + dir * 8 + head] + bias);
      float a0 = d0 * Ah, a1 = d1 * Ah;
      float P1 = wave_incl_scan(a0 + a1), P0 = P1 - a1;
      float tot = __shfl(P1, 63);
      if (dir == 0) { wts[2 * lane] = d0 * __expf(tot - P0); wts[2 * lane + 1] = d1 * __expf(tot - P1); }
      else { wts[128 + 2 * lane] = d0 * __expf(P0 - a0); wts[128 + 2 * lane + 1] = d1 * __expf(P1 - a1); }
      if (lane == 0) cdec[((dir * NB + b) * NCH + c) * 8 + head] = __expf(tot);
    }
#pragma unroll
    for (int i = 0; i < 8; ++i) {
      int id = tid + 256 * i, lrow = id >> 4, ch = (id & 15) * 8; float v[8];
      ssd_act8(bcact, rows0 + lrow, g * 128 + ch, v);
#pragma unroll
      for (int e = 0; e < 8; ++e) BT[(ch + e) * SL + lrow] = f2bf(v[e]);
    }
    float xv[4][8];
#pragma unroll
    for (int i = 0; i < 4; ++i) { int id = tid + 256 * i, lrow = id >> 3, ch = (id & 7) * 8; ssd_act8(xsact, rows0 + lrow, head * 64 + ch, xv[i]); }
    for (int dir = 0; dir < 2; ++dir) {
      __syncthreads();
#pragma unroll
      for (int i = 0; i < 4; ++i) { int id = tid + 256 * i, lrow = id >> 3, ch = (id & 7) * 8; float wv = wts[dir * 128 + lrow];
#pragma unroll
        for (int e = 0; e < 8; ++e) xT[(ch + e) * SL + lrow] = f2bf(xv[i][e] * wv); }
      __syncthreads();
      f32x16 acc[2][1]; acc[0][0] = zero16(); acc[1][0] = zero16();
      wave_mma<2, 1>(acc, xT, SL, BT + (32 * w) * SL, SL, 128);
      u16* st = (u16*)(p->ws + (dir ? A_STB : A_STF)) + ((size_t)((b * NCH + c) * 8 + head)) * 64 * 128;
#pragma unroll
      for (int i = 0; i < 2; ++i)
#pragma unroll
        for (int t = 0; t < 16; ++t) st[(i * 32 + crow(t, h)) * 128 + 32 * w + r] = f2bf(acc[i][0][t]);
    }
  }
}

DI void phase_ssd2(PP p) {
  const float* cdec = (const float*)(p->ws + S_CDEC);
  const int total = NB * 8 * 64 * 128;
  for (int i = get_bid() * 256 + get_tid(); i < total; i += gridDim.x * 256) {
    int dir = i / (NB * 8 * 4096), rem = i % (NB * 8 * 4096), b = rem / (8 * 4096), rem2 = rem % (8 * 4096), head = rem2 / 4096, pn2 = rem2 % 4096;
    unsigned* S = (unsigned*)(p->ws + (dir ? A_STB : A_STF));
    float s0 = 0.f, s1 = 0.f;
#pragma unroll 1
    for (int k0 = 0; k0 < NCH; k0 += 11) {
      unsigned stv[11]; float dc[11]; unsigned idx[11];
#pragma unroll
      for (int u = 0; u < 11; ++u) {
        int k = k0 + u; int c = dir == 0 ? k : (k < 2 ? 1 - k : NCH + 1 - k);
        idx[u] = (unsigned)(((b * NCH + c) * 8 + head) * 4096 + pn2);
        stv[u] = S[idx[u]]; dc[u] = cdec[((dir * NB + b) * NCH + c) * 8 + head];
      }
#pragma unroll
      for (int u = 0; u < 11; ++u) { S[idx[u]] = pack2(s0, s1); s0 = s0 * dc[u] + lo2f(stv[u]); s1 = s1 * dc[u] + hi2f(stv[u]); }
    }
  }
}

DI void phase_ssd3(PP p, int l, bool need_ctx, unsigned char* ldsb) {
  const int tid = get_tid(), lane = tid & 63, w = tid >> 6, r = lane & 31, h = lane >> 5;
  const u16* xsact = (const u16*)(p->ws + A_XSACT); const u16* bcact = (const u16*)(p->ws + A_BCACT); const float* dtraw = (const float*)(p->ws + S_DT);
  const float* cw = p->in[I_SCW] + (size_t)l * 5 * 1024; const float* cb = p->in[I_SCB] + l * 1024;
  u16* Cs = (u16*)ldsb; u16* Bs = Cs + 128 * SL; float* cum = (float*)(Bs + 128 * SL);
  u16* ybuf = (u16*)(p->ws + A_YBUF);
  for (int item = get_bid(); item < NB * NCH * 8; item += gridDim.x) {
    const int b = item / (NCH * 8), rem = item % (NCH * 8), c = rem >> 3, head = rem & 7, g = head >> 2;
    if (c < 2 && !need_ctx) continue;
    const int rows0 = b * TT + c * 128;
    const int lo = c < 2 ? b * TT : b * TT + CTX, hi = c < 2 ? b * TT + CTX : (b + 1) * TT;
    __syncthreads();
    if (w < 2) {
      const int dir = w;
      const float bias = p->in[I_SDTB][l * 16 + dir * 8 + head]; const float Ah = -__expf(p->in[I_SALOG][l * 16 + dir * 8 + head]);
      float d0 = softplusf(dtraw[(size_t)(rows0 + 2 * lane) * 16 + dir * 8 + head] + bias);
      float d1 = softplusf(dtraw[(size_t)(rows0 + 2 * lane + 1) * 16 + dir * 8 + head] + bias);
      float a0 = d0 * Ah, a1 = d1 * Ah;
      float P1 = wave_incl_scan(a0 + a1), P0 = P1 - a1;
      if (dir == 0) { cum[2 * lane] = P0; cum[2 * lane + 1] = P1; cum[128 + 2 * lane] = d0; cum[128 + 2 * lane + 1] = d1; }
      else { cum[256 + 2 * lane] = P0 - a0; cum[256 + 2 * lane + 1] = P1 - a1; cum[384 + 2 * lane] = d0; cum[384 + 2 * lane + 1] = d1; if (lane == 63) cum[512] = P1; }
    }
#pragma unroll 2
    for (int i = 0; i < 8; ++i) {
      int id = tid + 256 * i, lrow = id >> 4, ch = (id & 15) * 8; float v[8];
      ssd_act8(bcact, rows0 + lrow, 256 + g * 128 + ch, v);
      *(U4*)(Cs + lrow * SL + ch) = pack8(v);
      ssd_act8(bcact, rows0 + lrow, g * 128 + ch, v);
      *(U4*)(Bs + lrow * SL + ch) = pack8(v);
    }
    __syncthreads();
    f32x16 G[1][4]; for (int j = 0; j < 4; ++j) G[0][j] = zero16();
    wave_mma<1, 4>(G, Cs + (32 * w) * SL, SL, Bs, SL, 128);
    __syncthreads();
    {
      const u16* sf = (const u16*)(p->ws + A_STF) + ((size_t)((b * NCH + c) * 8 + head)) * 8192;
      const u16* sb = (const u16*)(p->ws + A_STB) + ((size_t)((b * NCH + c) * 8 + head)) * 8192;
#pragma unroll 2
      for (int i = 0; i < 4; ++i) {
        int id = tid + 256 * i, pp = id >> 4, n8 = (id & 15) * 8;
        *(U4*)(Bs + pp * SL + n8) = *(const U4*)(sf + pp * 128 + n8);
        *(U4*)(Bs + (64 + pp) * SL + n8) = *(const U4*)(sb + pp * 128 + n8);
      }
    }
    __syncthreads();
    f32x16 af[1][2], ab[1][2]; af[0][0] = zero16(); af[0][1] = zero16(); ab[0][0] = zero16(); ab[0][1] = zero16();
    wave_mma<1, 2>(af, Cs + (32 * w) * SL, SL, Bs, SL, 128);
    wave_mma<1, 2>(ab, Cs + (32 * w) * SL, SL, Bs + 64 * SL, SL, 128);
    f32x16 ad[1][2];
    { const float PbTot = cum[512];
#pragma unroll
      for (int j = 0; j < 2; ++j)
#pragma unroll
        for (int t = 0; t < 16; ++t) { const int lr = 32 * w + crow(t, h); ad[0][j][t] = __expf(cum[lr]) * af[0][j][t] + __expf(PbTot - cum[256 + lr]) * ab[0][j][t]; } }
    __syncthreads();
    {
#pragma unroll
      for (int j = 0; j < 4; ++j) {
        const int s = 32 * j + r; const float Pfs = cum[s], dtfs = cum[128 + s], Ebs = cum[256 + s], dtbs = cum[384 + s];
#pragma unroll
        for (int t = 0; t < 16; ++t) {
          const int lr = 32 * w + crow(t, h);
          float mf = (s <= lr) ? __expf(fminf(cum[lr] - Pfs, 0.f)) * dtfs : 0.f;
          float mb = (s >= lr) ? __expf(fminf(Ebs - cum[256 + lr], 0.f)) * dtbs : 0.f;
          Bs[lr * SL + s] = f2bf(G[0][j][t] * (mf + mb));
        }
      }
#pragma unroll 2
      for (int i = 0; i < 4; ++i) { int id = tid + 256 * i, lrow = id >> 3, ch = (id & 7) * 8; float v[8];
        ssd_act8(xsact, rows0 + lrow, head * 64 + ch, v);
#pragma unroll
        for (int e = 0; e < 8; ++e) Cs[(ch + e) * SL + lrow] = f2bf(v[e]); }
    }
    __syncthreads();
    wave_mma<1, 2>(ad, Bs + (32 * w) * SL, SL, Cs, SL, 128);
    const float Dh = p->in[I_SD][l * 8 + head];
#pragma unroll
    for (int j = 0; j < 2; ++j)
#pragma unroll
      for (int t = 0; t < 16; ++t) {
        const int lr = 32 * w + crow(t, h), pp = 32 * j + r;
        float y = ad[0][j][t] + Dh * bf2f(Cs[pp * SL + lr]);
        ybuf[(size_t)(rows0 + lr) * 512 + head * 64 + pp] = f2bf(y);
      }
  }
}

DI void phase_ssd4(PP p, int l, bool need_ctx) {
  const int lane = get_tid() & 63, w = get_tid() >> 6;
  u16* zx = (u16*)(p->ws + A_SSDZX); const u16* ybuf = (const u16*)(p->ws + A_YBUF); const float* gn = p->in[I_SNORM] + l * 512;
  for (int r = get_bid() * 4 + w; r < ROWS; r += gridDim.x * 4) {
    int t = r % TT; if (t < CTX && !need_ctx) continue;
    U4 yv = *(const U4*)(ybuf + (size_t)r * 512 + lane * 8), zv = *(const U4*)(zx + (size_t)r * 1536 + lane * 8);
    float y[8], z[8]; unpack8(yv, y); unpack8(zv, z);
    float ss = 0.f;
#pragma unroll
    for (int e = 0; e < 8; ++e) { y[e] *= siluf(z[e]); ss += y[e] * y[e]; }
    ss = wave_sum(ss); float rstd = rsqrtf(ss * (1.f / 512.f) + EPS);
#pragma unroll
    for (int e = 0; e < 8; ++e) y[e] *= rstd * gn[lane * 8 + e];
    *(U4*)(zx + (size_t)r * 1536 + lane * 8) = pack8(y);
  }
}

DI F2 cmul(F2 a, F2 b) { return mkf2(a.x * b.x - a.y * b.y, a.x * b.y + a.y * b.x); }
DI F2 cmulc(F2 a, F2 b) { return mkf2(a.x * b.x + a.y * b.y, a.y * b.x - a.x * b.y); }
#define LP(i) ((i) + ((i) >> 5))
DI F2 twid2(int j) { const float r = (float)j * (1.f / 16384.f); return mkf2(__builtin_amdgcn_cosf(r), -__builtin_amdgcn_sinf(r)); }
DI F2 twid(int k) { const float r = (float)k * (1.f / 8192.f); return mkf2(__builtin_amdgcn_cosf(r), -__builtin_amdgcn_sinf(r)); }
DI void fft_fwd(F2* L) {
  const int tid = get_tid();
#pragma unroll 1
  for (int s = 0; s < 12; s += 2) {
    const int hB = 2048 >> s, lg = 11 - s;
#pragma unroll 8
    for (int g = tid; g < 2048; g += 256) {
      const int pos = g & (hB - 1), grp = g >> lg;
      const int i0 = (grp << (lg + 2)) + pos;
      F2 x0 = L[LP(i0)], x1 = L[LP(i0 + hB)], x2 = L[LP(i0 + 2 * hB)], x3 = L[LP(i0 + 3 * hB)];
      const F2 wA = twid(pos << s); const F2 wA2 = mkf2(wA.y, -wA.x); const F2 wB = cmul(wA, wA);
      F2 a0 = mkf2(x0.x + x2.x, x0.y + x2.y), a2 = cmul(mkf2(x0.x - x2.x, x0.y - x2.y), wA);
      F2 a1 = mkf2(x1.x + x3.x, x1.y + x3.y), a3 = cmul(mkf2(x1.x - x3.x, x1.y - x3.y), wA2);
      L[LP(i0)] = mkf2(a0.x + a1.x, a0.y + a1.y); L[LP(i0 + hB)] = cmul(mkf2(a0.x - a1.x, a0.y - a1.y), wB);
      L[LP(i0 + 2 * hB)] = mkf2(a2.x + a3.x, a2.y + a3.y); L[LP(i0 + 3 * hB)] = cmul(mkf2(a2.x - a3.x, a2.y - a3.y), wB);
    }
    __syncthreads();
  }
#pragma unroll 8
  for (int q = tid; q < 4096; q += 256) { F2 u = L[LP(2 * q)], v = L[LP(2 * q + 1)]; L[LP(2 * q)] = mkf2(u.x + v.x, u.y + v.y); L[LP(2 * q + 1)] = mkf2(u.x - v.x, u.y - v.y); }
  __syncthreads();
}
DI void fft_inv(F2* L) {
  const int tid = get_tid();
#pragma unroll 8
  for (int q = tid; q < 4096; q += 256) { F2 u = L[LP(2 * q)], v = L[LP(2 * q + 1)]; L[LP(2 * q)] = mkf2(u.x + v.x, u.y + v.y); L[LP(2 * q + 1)] = mkf2(u.x - v.x, u.y - v.y); }
  __syncthreads();
#pragma unroll 1
  for (int s = 10; s >= 0; s -= 2) {
    const int hB = 2048 >> s, lg = 11 - s;
#pragma unroll 8
    for (int g = tid; g < 2048; g += 256) {
      const int pos = g & (hB - 1), grp = g >> lg;
      const int i0 = (grp << (lg + 2)) + pos;
      F2 y0 = L[LP(i0)], y1 = L[LP(i0 + hB)], y2 = L[LP(i0 + 2 * hB)], y3 = L[LP(i0 + 3 * hB)];
      const F2 wA = twid(pos << s); const F2 wA2 = mkf2(wA.y, -wA.x); const F2 wB = cmul(wA, wA);
      F2 v1 = cmulc(y1, wB), v3 = cmulc(y3, wB);
      F2 a0 = mkf2(y0.x + v1.x, y0.y + v1.y), a1 = mkf2(y0.x - v1.x, y0.y - v1.y);
      F2 a2 = mkf2(y2.x + v3.x, y2.y + v3.y), a3 = mkf2(y2.x - v3.x, y2.y - v3.y);
      F2 u2 = cmulc(a2, wA), u3 = cmulc(a3, wA2);
      L[LP(i0)] = mkf2(a0.x + u2.x, a0.y + u2.y); L[LP(i0 + 2 * hB)] = mkf2(a0.x - u2.x, a0.y - u2.y);
      L[LP(i0 + hB)] = mkf2(a1.x + u3.x, a1.y + u3.y); L[LP(i0 + 3 * hB)] = mkf2(a1.x - u3.x, a1.y - u3.y);
    }
    __syncthreads();
  }
}
DI float hy_delta(int c) {
  const float a = -4.605170185988091f / 1.5f, bq = -4.605170185988091f / 0.3f;
  return fabsf(a + (bq - a) * ((float)c / 511.f));
}
DI float block_sum(float v, float* red  ) {
  v = wave_sum(v);
  __syncthreads();
  if ((get_tid() & 63) == 0) red[get_tid() >> 6] = v;
  __syncthreads();
  return red[0] + red[1] + red[2] + red[3];
}

DI void phase_hyspec(PP p, int l, TileIter& it, unsigned char* ldsb) {
  const int tid = get_tid();
  F2* L = (F2*)ldsb; float* misc = (float*)(ldsb + 67584);
  float* tmpF = (float*)ldsb; float* tmpB = tmpF + FN;
  const F2* W2 = (const F2*)(p->ws + S_W2); const u16* hid = (const u16*)(p->ws + S_HID);
  const float* w3 = p->in[I_HW3] + (size_t)l * 64 * 2048;
  F2* Gs = (F2*)(p->ws + A_GSPEC);
  FOR_TILES(it, 1024, item) {
    const int o = item >> 9, c = item & 511;
    __syncthreads();
    if (tid < 64) misc[tid] = w3[tid * 2048 + o * 512 + c]; else if (tid < 128) misc[tid] = w3[(tid - 64) * 2048 + 1024 + o * 512 + c];
    __syncthreads();
    const float delta = hy_delta(c);
    float ss = 0.f;
#pragma unroll 1
    for (int i = 0; i < 32; ++i) {
      const int t = tid + 256 * i; const u16* hr = hid + (size_t)t * 64;
      float df = 0.f, db = 0.f;
#pragma unroll
      for (int k8 = 0; k8 < 8; ++k8) { U4 hq = *(const U4*)(hr + k8 * 8); float hv[8]; unpack8(hq, hv);
#pragma unroll
        for (int e = 0; e < 8; ++e) { df += hv[e] * misc[k8 * 8 + e]; db += hv[e] * misc[64 + k8 * 8 + e]; } }
      const float dec = __expf(-((float)t / 8191.f) * delta);
      df *= dec; db *= dec; tmpF[t] = df; tmpB[t] = db;
      ss += (t == 0) ? (df + db) * (df + db) : (df * df + db * db);
    }
    ss = block_sum(ss, misc + 128);
    const float scale = rsqrtf(ss + EPS) * (1.f / 16384.f);
    F2* zs = (F2*)(p->ws + A_ZSAVE) + (size_t)get_bid() * FN;
#pragma unroll 8
    for (int i = 0; i < 32; ++i) { int j = tid + 256 * i; zs[j] = mkf2(tmpF[j] * scale, tmpB[j == 0 ? 0 : FN - j] * scale); }
    __syncthreads();
#pragma unroll 8
    for (int i = 0; i < 32; ++i) { int j = tid + 256 * i; F2 v = zs[j]; L[LP(j)] = mkf2(v.x + v.y, 0.f); }
    __syncthreads();
    fft_fwd(L);
    F2* dst = Gs + (size_t)item * 2 * FN;
#pragma unroll 8
    for (int i = 0; i < 32; ++i) dst[tid + 256 * i] = L[LP(tid + 256 * i)];
    __syncthreads();
#pragma unroll 8
    for (int i = 0; i < 32; ++i) { int j = tid + 256 * i; F2 v = zs[j]; float gv = (j == 0 ? v.x + v.y : v.x - v.y); F2 wv = twid2(j); L[LP(j)] = mkf2(gv * wv.x, gv * wv.y); }
    __syncthreads();
    fft_fwd(L);
#pragma unroll 8
    for (int i = 0; i < 32; ++i) dst[FN + tid + 256 * i] = L[LP(tid + 256 * i)];
  }
  it.off += 1024;
}

DI float hy_u_lat_sh(const u16* PT, int b, int col, int j, float w0, float w1, float w2, float bias) {
  const u16* rowp = PT + ((size_t)b * 1536 + col) * TT + CTX;
  const int lane = get_tid() & 63;
  const float c = bf2f(rowp[j]);
  float lft = __shfl_up(c, 1), rgt = __shfl_down(c, 1);
  if (lane == 0) lft = (j > 0) ? bf2f(rowp[j - 1]) : 0.f;
  if (lane == 63) rgt = (j < SEQ - 1) ? bf2f(rowp[j + 1]) : 0.f;
  return bias + w1 * c + w0 * lft + w2 * rgt;
}
DI float hy_u_lat(const u16* PT, int b, int col, int j, float w0, float w1, float w2, float bias) {
  const u16* rowp = PT + ((size_t)b * 1536 + col) * TT + CTX;
  float v = bias + w1 * bf2f(rowp[j]);
  if (j > 0) v += w0 * bf2f(rowp[j - 1]);
  if (j < SEQ - 1) v += w2 * bf2f(rowp[j + 1]);
  return v;
}
DI float hy_u_ctx(const u16* PT, int b, int col, int j, float w0, float w1, float w2, float bias) {
  const u16* rowp = PT + ((size_t)b * 1536 + col) * TT;
  float v = bias + w1 * bf2f(rowp[j]);
  if (j > 0) v += w0 * bf2f(rowp[j - 1]);
  if (j < CTX - 1) v += w2 * bf2f(rowp[j + 1]);
  return v;
}

DI void phase_hyconv(PP p, int l, bool need_ctx, unsigned char* ldsb) {
  const int tid = get_tid();
  F2* L = (F2*)ldsb; float* misc = (float*)(ldsb + 67584);
  const F2* W2 = (const F2*)(p->ws + S_W2);
  const u16* PT = (const u16*)(p->ws + A_PTHY); const F2* Gs = (const F2*)(p->ws + A_GSPEC);
  u16* ohy = (u16*)(p->ws + A_OHY);
  const float* cw = p->in[I_HCW] + (size_t)l * 3 * 1536; const float* cb = p->in[I_HCB] + l * 1536; const float* hb = p->in[I_HBIAS] + l * 1024;
  const int nlat = 1024, nctx = need_ctx ? 512 : 0;
  for (int item = get_bid(); item < nlat + nctx; item += gridDim.x) {
    __syncthreads();
    if (item < nlat) {
      const int bp = item >> 9, c = item & 511, b0 = 2 * bp, b1 = b0 + 1;
      unsigned* zs = (unsigned*)(p->ws + A_ZSAVE) + (size_t)get_bid() * FN;
      unsigned* ys = (unsigned*)(p->ws + A_YSAVE) + (size_t)get_bid() * FN;
      { const float w0 = cw[c], w1 = cw[1536 + c], w2 = cw[3072 + c], bi = cb[c];
#pragma unroll 4
        for (int i = 0; i < 32; ++i) { int j = tid + 256 * i; F2 z = mkf2(hy_u_lat(PT, b0, c, j, w0, w1, w2, bi), hy_u_lat(PT, b1, c, j, w0, w1, w2, bi)); const unsigned zp = pack2(z.x, z.y); zs[j] = zp; L[LP(j)] = mkf2(lo2f(zp), hi2f(zp)); } }
      __syncthreads();
#pragma unroll 1
      for (int o = 0; o < 2; ++o) {
        const F2* Ge = Gs + ((size_t)(o * 512 + c) * 2) * FN; const F2* Go = Ge + FN;
        fft_fwd(L);
#pragma unroll 16
        for (int i = 0; i < 32; ++i) { int k = tid + 256 * i; L[LP(k)] = cmul(L[LP(k)], Ge[k]); }
        __syncthreads();
        fft_inv(L);
#pragma unroll 8
        for (int i = 0; i < 32; ++i) { int j = tid + 256 * i; F2 yv = L[LP(j)]; ys[j] = pack2(yv.x, yv.y); }
        __syncthreads();
#pragma unroll 8
        for (int i = 0; i < 32; ++i) { int j = tid + 256 * i; unsigned zp = zs[j]; L[LP(j)] = cmul(mkf2(lo2f(zp), hi2f(zp)), twid2(j)); }
        __syncthreads();
        fft_fwd(L);
#pragma unroll 16
        for (int i = 0; i < 32; ++i) { int k = tid + 256 * i; L[LP(k)] = cmul(L[LP(k)], Go[k]); }
        __syncthreads();
        fft_inv(L);
        const int col = (1 + o) * 512 + c;
        const float w0 = cw[col], w1 = cw[1536 + col], w2 = cw[3072 + col], bi = cb[col], hbias = hb[o * 512 + c];
#pragma unroll 4
        for (int i = 0; i < 32; ++i) { int j = tid + 256 * i; F2 yo = cmulc(L[LP(j)], twid2(j)); unsigned yp = ys[j], zp = zs[j]; F2 ye = mkf2(lo2f(yp), hi2f(yp)); F2 z = mkf2(lo2f(zp), hi2f(zp));
          float yr = ye.x + yo.x, yi = ye.y + yo.y;
          float zr = hy_u_lat(PT, b0, col, j, w0, w1, w2, bi) * (yr + hbias * z.x);
          float zi = hy_u_lat(PT, b1, col, j, w0, w1, w2, bi) * (yi + hbias * z.y);
          if (o == 0) { const unsigned zq = pack2(zr, zi); zs[j] = zq; L[LP(j)] = mkf2(lo2f(zq), hi2f(zq)); }
          else { ohy[((size_t)b0 * TT + CTX + j) * 512 + c] = f2bf(zr); ohy[((size_t)b1 * TT + CTX + j) * 512 + c] = f2bf(zi); } }
        __syncthreads();
      }
    } else {
      const int c = item - nlat, t = tid;
      float* g = (float*)ldsb;
      float* zs = g + 1024;
      float* wv = zs + 256;
      float* red = wv + 256;
      const float* hidc = (const float*)(p->ws + S_HIDC); const float* w3 = p->in[I_HW3] + (size_t)l * 64 * 2048;
      { int which = tid >> 6, k = tid & 63; int dir = which >> 1, o = which & 1; wv[tid] = w3[k * 2048 + dir * 1024 + o * 512 + c]; }
      __syncthreads();
      const float dec = __expf(-((float)t / 255.f) * hy_delta(c));
      float f[2], bk[2];
      { float d[4] = {0.f, 0.f, 0.f, 0.f};
#pragma unroll 4
        for (int k = 0; k < 64; ++k) { float hv = hidc[t * 64 + k]; d[0] += hv * wv[k]; d[1] += hv * wv[64 + k]; d[2] += hv * wv[128 + k]; d[3] += hv * wv[192 + k]; }
        f[0] = d[0] * dec; f[1] = d[1] * dec; bk[0] = d[2] * dec; bk[1] = d[3] * dec; }
      for (int o = 0; o < 2; ++o) {
        float ss = (t == 0) ? (f[o] + bk[o]) * (f[o] + bk[o]) : (f[o] * f[o] + bk[o] * bk[o]);
        ss = block_sum(ss, red);
        float sc = rsqrtf(ss + EPS);
        if (t == 0) { g[o * 512] = (f[o] + bk[o]) * sc; g[o * 512 + 256] = 0.f; }
        else { g[o * 512 + t] = f[o] * sc; g[o * 512 + 512 - t] = bk[o] * sc; }
      }
      __syncthreads();
#pragma unroll 1
      for (int b = 0; b < NB; ++b) {
        float z = hy_u_ctx(PT, b, c, t, cw[c], cw[1536 + c], cw[3072 + c], cb[c]);
        for (int o = 0; o < 2; ++o) {
          __syncthreads();
          zs[t] = z;
          __syncthreads();
          float y = 0.f;
#pragma unroll 4
          for (int s = 0; s < 256; ++s) y += zs[s] * g[o * 512 + ((t - s) & 511)];
          const int col = (1 + o) * 512 + c;
          z = hy_u_ctx(PT, b, col, t, cw[col], cw[1536 + col], cw[3072 + col], cb[col]) * (y + hb[o * 512 + c] * z);
        }
        ohy[((size_t)b * TT + t) * 512 + c] = f2bf(z);
      }
    }
  }
}

DI void phase_merge(PP p, u16* lds, bool skipc) {
  unsigned char* ws = p->ws;
  const u16* H = (const u16*)(ws + H_OFF); const u16* Wg = (const u16*)(ws + W_WIN) + (size_t)OFF_GATE * DM; const u16* Wbr = (const u16*)(ws + W_BR);
  u16* mixed = (u16*)(ws + A_MIXED);
  const int ntile = (skipc ? NB * 64 : ROWS / 128) * 8;
  for (int ti = get_bid(); ti < ntile; ti += gridDim.x) {
    int tm = ti >> 3, tn = ti & 7;
    if (skipc) tm = NCH * (tm >> 6) + 2 + (tm & 63);
    unsigned amp[2][2][8];
#pragma unroll
    for (int a = 0; a < 2; ++a)
#pragma unroll
      for (int bq = 0; bq < 2; ++bq)
#pragma unroll
        for (int t = 0; t < 8; ++t) amp[a][bq][t] = 0u;
#pragma unroll 1
    for (int i = 0; i < 4; ++i) {
      unsigned gp[2][2][8];
      {
        f32x16 ag[2][2]; zero_acc<2>(ag);
        gemm_acc<2>(ag, H + (size_t)tm * 128 * DM, DM, Wg + ((size_t)i * 1024 + tn * 128) * DM, DM, DM, lds);
#pragma unroll
        for (int a = 0; a < 2; ++a)
#pragma unroll
          for (int bq = 0; bq < 2; ++bq)
#pragma unroll
            for (int t = 0; t < 8; ++t) gp[a][bq][t] = pack2(sigmoidf(ag[a][bq][2 * t]), sigmoidf(ag[a][bq][2 * t + 1]));
      }
      f32x16 ao[2][2]; zero_acc<2>(ao);
      const u16* Oi = (const u16*)(ws + (i == 0 ? A_DAQ : i == 1 ? A_SSDZX : i == 2 ? A_OMLA : A_OHY)); const int ldi = (i == 1) ? 1536 : 512;
      gemm_acc<2>(ao, Oi + (size_t)tm * 128 * ldi, ldi, Wbr + ((size_t)i * 1024 + tn * 128) * 512, 512, 512, lds);
#pragma unroll
      for (int a = 0; a < 2; ++a)
#pragma unroll
        for (int bq = 0; bq < 2; ++bq)
#pragma unroll
          for (int t = 0; t < 8; ++t) amp[a][bq][t] = pack2(lo2f(amp[a][bq][t]) + lo2f(gp[a][bq][t]) * ao[a][bq][2 * t], hi2f(amp[a][bq][t]) + hi2f(gp[a][bq][t]) * ao[a][bq][2 * t + 1]);
    }
    f32x16 am[2][2];
#pragma unroll
    for (int a = 0; a < 2; ++a)
#pragma unroll
      for (int bq = 0; bq < 2; ++bq)
#pragma unroll
        for (int t = 0; t < 8; ++t) { am[a][bq][2 * t] = lo2f(amp[a][bq][t]); am[a][bq][2 * t + 1] = hi2f(amp[a][bq][t]); }
    store_tile_bf16<2>(am, mixed, DM, tm * 128, tn * 128, DM);
  }
}

DI void phase_ffn1(PP p, u16* lds, bool skipc) {
  unsigned char* ws = p->ws;
  const u16* H = (const u16*)(ws + H_OFF); const u16* W1 = (const u16*)(ws + W_F1); const u16* W3 = (const u16*)(ws + W_F3);
  u16* act = (u16*)(ws + A_ACT);
  const int ntn = FFN / 128, ntile = (skipc ? NB * 64 : ROWS / 128) * ntn;
  for (int ti = get_bid(); ti < ntile; ti += gridDim.x) {
    int tm = ti / ntn, tn = ti % ntn;
    if (skipc) tm = NCH * (tm >> 6) + 2 + (tm & 63);
    f32x16 a1[2][2], a3[2][2]; zero_acc<2>(a1); zero_acc<2>(a3);
    gemm_acc<2>(a1, H + (size_t)tm * 128 * DM, DM, W1 + (size_t)tn * 128 * DM, DM, DM, lds);
    gemm_acc<2>(a3, H + (size_t)tm * 128 * DM, DM, W3 + (size_t)tn * 128 * DM, DM, DM, lds);
#pragma unroll
    for (int a = 0; a < 2; ++a)
#pragma unroll
      for (int bq = 0; bq < 2; ++bq)
#pragma unroll
        for (int t = 0; t < 16; ++t) a1[a][bq][t] = siluf(a1[a][bq][t]) * a3[a][bq][t];
    store_tile_bf16<2>(a1, act, FFN, tm * 128, tn * 128, FFN);
  }
}

DI void phase_gemm_mla(PP p, u16* lds) {
  unsigned char* ws = p->ws;
  const u16* mc = (const u16*)(ws + A_MLAC);
  TileIter it{0};
  gemm_job(it, mc, 704, (const u16*)(ws + W_UQ), 384, 384, 768, 0, ws + A_MLAQ, 768, lds);
  const u16* Wkv = (const u16*)(ws + W_UKV);
  const int ntile = (ROWS / 128) * 8;
  FOR_TILES(it, ntile, ti) {
    int tm = ti >> 3, tn = ti & 7, hd = tn >> 1;
    f32x16 acc[2][2]; zero_acc<2>(acc);
    if ((tn & 1) == 0) {
      gemm_acc<2, true>(acc, mc + (size_t)tm * 128 * 704 + 384, 704, Wkv + (size_t)tn * 128 * 256, 256, 256, lds);
      store_tile_bf16<2>(acc, (u16*)(ws + A_MLAKN), 512, tm * 128, hd * 128, 512);
    } else {
      gemm_acc<2, false>(acc, mc + (size_t)tm * 128 * 704 + 384, 704, Wkv + (size_t)tn * 128 * 256, 256, 256, lds);
      store_tile_T(acc, (u16*)(ws + A_MLAVT), 512, tm * 128, hd * 128);
    }
  }
}


#define XB_TMO      128
#define XB_XCNT(j)  (256  + 64 * (j))
#define XB_XSUB(j)  (1280 + 64 * (j))
#define XB_XGEN(j)  (2304 + 64 * (j))
#define XB_TOP      3328
#define XB_TOPGEN   3392
#define XCD_BAR_WORDS 3456
#define XB_SPIN_CAP (1u << 20)
#define LAS __attribute__((address_space(3)))
DI unsigned xb_ld(unsigned* p)              { return __hip_atomic_load(p, __ATOMIC_RELAXED, __HIP_MEMORY_SCOPE_AGENT); }
DI unsigned xb_add(unsigned* p, unsigned v) { return __hip_atomic_fetch_add(p, v, __ATOMIC_RELAXED, __HIP_MEMORY_SCOPE_AGENT); }
DI unsigned xb_xcc_id() { return (unsigned)__builtin_amdgcn_s_getreg((3 << 11) | 20) & 0xFu; }
#define XB_SPIN(cond, bar) do { unsigned _sp = 0; while (cond) { __builtin_amdgcn_s_sleep(1); \
    if ((++_sp & 255u) == 0u) { if (xb_ld(&(bar)[XB_TMO])) break; if (_sp > XB_SPIN_CAP) { atomicAdd(&(bar)[XB_TMO], 1u); break; } } } } while (0)
struct XcdBarrier { unsigned* bar; unsigned x; volatile LAS unsigned* st; };
DI XcdBarrier xcd_barrier_post(unsigned* bar, volatile LAS unsigned* st) {
  XcdBarrier b; b.bar = bar; b.x = xb_xcc_id(); b.st = st;
  if (threadIdx.x == 0) (void)xb_add(&bar[XB_XCNT(b.x)], 1u);
  return b;
}
DI void xcd_barrier_complete(unsigned* bar, unsigned x, unsigned& nloc, unsigned& nx) {
  const unsigned G = gridDim.x * gridDim.y * gridDim.z;
  unsigned sum, cnt, mine, sp = 0u;
  for (;;) {
    sum = 0u; cnt = 0u; mine = 0u;
#pragma unroll
    for (unsigned j = 0; j < 16; ++j) { const unsigned c = xb_ld(&bar[XB_XCNT(j)]); sum += c; cnt += (c > 0u) ? 1u : 0u; mine = (j == x) ? c : mine; }
    if (sum == G) break;
    __builtin_amdgcn_s_sleep(1);
    if ((++sp & 255u) == 0u) { if (xb_ld(&bar[XB_TMO])) break; if (sp > XB_SPIN_CAP) { atomicAdd(&bar[XB_TMO], 1u); break; } }
  }
  nloc = mine > 0u ? mine : 1u; nx = cnt > 0u ? cnt : 1u;
}
DI void xcd_barrier(const XcdBarrier& b) {
  asm volatile("s_waitcnt vmcnt(0)" ::: "memory");
  __syncthreads();
  if (threadIdx.x == 0) {
    unsigned* bar = b.bar;
    __builtin_amdgcn_s_waitcnt(0);
    unsigned nloc = b.st[0], nx = b.st[1];
    if (nloc == 0u) { xcd_barrier_complete(bar, b.x, nloc, nx); b.st[0] = nloc; b.st[1] = nx; }
    const unsigned old = xb_add(&bar[XB_XSUB(b.x)], 1u);
    const unsigned gen = old / nloc;
    if (old + 1u == (gen + 1u) * nloc) {
      __builtin_amdgcn_fence(__ATOMIC_RELEASE, "agent");
      asm volatile("s_waitcnt vmcnt(0)" ::: "memory");
      const unsigned og = xb_add(&bar[XB_TOP], 1u);
      const unsigned tg = og / nx;
      if (og + 1u == (tg + 1u) * nx) xb_add(&bar[XB_TOPGEN], 1u);
      else XB_SPIN(xb_ld(&bar[XB_TOPGEN]) == tg, bar);
      __builtin_amdgcn_fence(__ATOMIC_ACQUIRE, "agent");
      xb_add(&bar[XB_XGEN(b.x)], 1u);
      asm volatile("s_waitcnt vmcnt(0)" ::: "memory");
    } else {
      XB_SPIN(xb_ld(&bar[XB_XGEN(b.x)]) == gen, bar);
      __builtin_amdgcn_fence(__ATOMIC_ACQUIRE, "agent");
      asm volatile("s_waitcnt vmcnt(0)" ::: "memory");
    }
  }
  __syncthreads();
}

constexpr int NPH = 21;
__host__ __device__ inline bool phase_empty(int ph) { int l = ph / NPH, k = ph % NPH; return l == 1 && (k == 1 || k == 2); }

DI void run_phase(PP p, int ph, unsigned char* lds) {
  const int l = ph / NPH, k = ph % NPH;
  const bool last = (l == 1), need_ctx = !last;
  unsigned char* ws = p->ws;
  const u16* H = (const u16*)(ws + H_OFF);
  const u16* Win = (const u16*)(ws + W_WIN);
#ifdef ONLY_PHASE
  if (k != ONLY_PHASE) return;
#endif
  switch (k) {
    case 0: phase_conv(p, l, lds); break;
    case 1: phase_modfin(p); break;
    case 2: phase_rowwise(p, true, nullptr, nullptr, 0, 0, true, p->in[I_NMPRE], 0, 0, 1, false); break;
    case 3: { TileIter it{0};
      gemm_job(it, H, DM, Win + (size_t)OFF_HY * DM, DM, DM, 1536, 2, ws + A_PTHY, 0, (u16*)lds, last);
      phase_hyspec(p, l, it, lds); } break;
    case 4: phase_hyconv(p, l, need_ctx, lds); break;
    case 5: { TileIter it{0};
      gemm_job(it, H, DM, Win + (size_t)(OFF_DA + 0) * DM, DM, DM, 512, 0, ws + A_DAQ, 512, (u16*)lds);
      gemm_job(it, H, DM, Win + (size_t)(OFF_DA + 512) * DM, DM, DM, 512, 0, ws + A_DAK, 512, (u16*)lds);
      gemm_job(it, H, DM, Win + (size_t)(OFF_DA + 1024) * DM, DM, DM, 512, 2, ws + A_DAVT, 0, (u16*)lds);
      gemm_job(it, H, DM, Win + (size_t)OFF_MLA * DM, DM, DM, 704, 0, ws + A_MLAC, 704, (u16*)lds); } break;
    case 6: phase_rope(p, l); break;
    case 7: phase_gemm_mla(p, (u16*)lds); break;
    case 8: phase_attn(p, l, need_ctx, lds);
#ifdef PROBE_MLA
      phase_attn(p, l, need_ctx, lds, 1);
#endif
      break;
    case 9: { TileIter it{0};
      gemm_job(it, H, DM, Win + (size_t)OFF_SSD * DM, DM, DM, 1536, 0, ws + A_SSDZX, 1536, (u16*)lds);
      gemm_job(it, H, DM, Win + (size_t)(OFF_SSD + 1536) * DM, DM, DM, 16, 1, ws + S_DT, 16, (u16*)lds); } break;
    case 10: phase_ssdconv(p, l); break;
    case 11: phase_ssd1(p, l, lds); break;
    case 12: phase_ssd2(p); break;
    case 13: phase_ssd3(p, l, need_ctx, lds); break;
    case 14: phase_ssd4(p, l, need_ctx); break;
    case 15: phase_merge(p, (u16*)lds, last); break;
    case 16: { TileIter it{0}; gemm_job(it, (const u16*)(ws + A_MIXED), DM, (const u16*)(ws + W_OUT), DM, DM, DM, 0, ws + A_YOUT, DM, (u16*)lds, last); } break;
    case 17: phase_rowwise(p, l == 0, (const u16*)(ws + A_YOUT), p->in[I_NMPOST] + l * DM, l, 2, true, p->in[I_NFPRE] + l * DM, l, 3, 4, last); break;
    case 18: phase_ffn1(p, (u16*)lds, last); break;
    case 19: { TileIter it{0}; gemm_job(it, (const u16*)(ws + A_ACT), FFN, (const u16*)(ws + W_F2), FFN, FFN, DM, 0, ws + A_F, DM, (u16*)lds, last); } break;
    case 20: phase_rowwise(p, false, (const u16*)(ws + A_F), p->in[I_NFPOST] + l * DM, l, 5, !last, p->in[I_NMPRE] + (last ? 0 : (l + 1) * DM), last ? l : l + 1, 0, 1, last); break;
  }
}

__global__ void __launch_bounds__(256, 2) mega_kernel(Params p_unused, int ph_lo, int ph_hi) {
  extern __shared__ __attribute__((aligned(16))) unsigned char lds[];
  __shared__ uint4 xb_words;
  cg::grid_group grid = cg::this_grid();
  PP pp = (PP)__builtin_amdgcn_kernarg_segment_ptr();
  if (threadIdx.x == 0) xb_words = make_uint4(0u, 0u, 0u, 0u);
  __syncthreads();
  XcdBarrier xb = xcd_barrier_post((unsigned*)(pp->ws + S_BAR), (volatile LAS unsigned*)&xb_words);
  int nsync = 0;
  if (ph_lo < 0) grid.sync();
  bool first = true;
  for (int ph = ph_lo; ph < ph_hi; ++ph) {
    if (phase_empty(ph)) continue;
    if (!first) {
      xcd_barrier(xb);
      ++nsync;
    }
    first = false;
    PP q = pp; asm volatile("" : "+s"(q));
    run_phase(q, ph, lds);
  }
}

extern "C" void kernel_launch(void* const* d_in, const int* in_sizes, int n_in, void* d_out, int out_size, void* d_ws, size_t ws_size, hipStream_t stream) {
  static int grid_blocks = 0;
  if (grid_blocks == 0) {
    if (n_in != N_IN || ws_size < WS_NEED) { fprintf(stderr, "kernel_launch: unexpected n_in %d / ws %zu\n", n_in, ws_size); grid_blocks = -1; return; }
    int dev = 0, cus = 0, per_cu = 0;
    hipGetDevice(&dev);
    hipDeviceGetAttribute(&cus, hipDeviceAttributeMultiprocessorCount, dev);
    if (hipFuncSetAttribute((const void*)mega_kernel, hipFuncAttributeMaxDynamicSharedMemorySize, LDS_BYTES) != hipSuccess) { fprintf(stderr, "hipFuncSetAttribute failed\n"); }
    hipOccupancyMaxActiveBlocksPerMultiprocessor(&per_cu, (const void*)mega_kernel, 256, LDS_BYTES);
    if (per_cu < 1) per_cu = 1;
    if (per_cu > 2) per_cu = 2;
    grid_blocks = cus * per_cu;
    fprintf(stderr, "kernel_launch: cus %d per_cu %d grid %d\n", cus, per_cu, grid_blocks);
  }
  if (grid_blocks < 0) return;
  Params p{};
  for (int i = 0; i < N_IN; ++i) p.in[i] = (const float*)d_in[i];
  p.out = (float*)d_out; p.ws = (unsigned char*)d_ws;
  if (hipMemsetAsync((unsigned char*)d_ws + S_BAR, 0, 16384, stream) != hipSuccess) { fprintf(stderr, "memset of barrier words failed\n"); return; }
#if MEGA
  int lo = 0, hi = 2 * NPH;
  void* args[] = {&p, &lo, &hi};
  hipError_t e = hipLaunchCooperativeKernel((const void*)mega_kernel, dim3(grid_blocks), dim3(256), args, LDS_BYTES, stream);
  if (e != hipSuccess) fprintf(stderr, "cooperative launch failed: %s\n", hipGetErrorString(e));
#else
  for (int ph = 0; ph < 2 * NPH; ++ph) {
    if (phase_empty(ph)) continue;
    hipLaunchKernelGGL(mega_kernel, dim3(grid_blocks), dim3(256), LDS_BYTES, stream, p, ph, ph + 1);
  }
#endif
}
```

```cpp
#include <hip/hip_runtime.h>
#include <hip/hip_cooperative_groups.h>
#include <cstdio>
#include <cstdint>
namespace cg = cooperative_groups;

#ifndef MEGA
#define MEGA 1
#endif

#define DI __device__ __forceinline__
typedef unsigned short u16;
typedef __attribute__((ext_vector_type(8))) short bf16x8;
typedef __attribute__((ext_vector_type(16))) float f32x16;
typedef __attribute__((ext_vector_type(4))) unsigned U4;
typedef __attribute__((ext_vector_type(2))) unsigned U2;
typedef __attribute__((ext_vector_type(4))) float F4;
typedef __attribute__((ext_vector_type(2))) float F2;
__device__ __forceinline__ U4 mku4(unsigned a, unsigned b, unsigned c, unsigned d) { U4 v = {a, b, c, d}; return v; }
__device__ __forceinline__ U2 mku2(unsigned a, unsigned b) { U2 v = {a, b}; return v; }
__device__ __forceinline__ F4 mkf4(float a, float b, float c, float d) { F4 v = {a, b, c, d}; return v; }
__device__ __forceinline__ F2 mkf2(float a, float b) { F2 v = {a, b}; return v; }
#define MFMA(a, b, c) __builtin_amdgcn_mfma_f32_32x32x16_bf16((a), (b), (c), 0, 0, 0)

constexpr int NB = 4, SEQ = 8192, DM = 1024, CTX = 256, TT = SEQ + CTX, ROWS = NB * TT;
constexpr int IN_COLS = 9424, OFF_DA = 0, OFF_SSD = 1536, OFF_MLA = 3088, OFF_HY = 3792, OFF_GATE = 5328;
constexpr int FFN = 2816;
constexpr float EPS = 1e-6f;
constexpr int NCH = TT / 128;
constexpr int FN = 8192;

enum { I_X = 0, I_C, I_CTX, I_CCTX, I_MODW, I_MODB, I_NMPRE, I_NMPOST, I_NFPRE, I_NFPOST, I_WIN, I_DALAM, I_DASUB,
       I_SCW, I_SCB, I_SALOG, I_SDTB, I_SD, I_SNORM, I_MQN, I_WUQ, I_MKVN, I_WUKV, I_HCW, I_HCB, I_HW1, I_HB1, I_HF1,
       I_HW2, I_HB2, I_HF2, I_HW3, I_HBIAS, I_WBDA, I_WBSSD, I_WBMLA, I_WBHY, I_WOUT, I_W1, I_W3, I_W2, N_IN };

struct Params { const float* in[N_IN]; float* out; unsigned char* ws; };
typedef const __attribute__((address_space(4))) Params* PP;

constexpr size_t MiB = 1048576;
constexpr size_t W_WIN = 0;
constexpr size_t W_UQ = W_WIN + (size_t)9552 * 1024 * 2;
constexpr size_t W_UKV = W_UQ + (size_t)768 * 384 * 2;
constexpr size_t W_BR = W_UKV + (size_t)1024 * 256 * 2;
constexpr size_t W_OUT = W_BR + (size_t)4 * 1024 * 512 * 2;
constexpr size_t W_F1 = W_OUT + (size_t)1024 * 1024 * 2;
constexpr size_t W_F3 = W_F1 + (size_t)2816 * 1024 * 2;
constexpr size_t W_F2 = W_F3 + (size_t)2816 * 1024 * 2;
constexpr size_t W_END = W_F2 + (size_t)2816 * 1024 * 2;
static_assert(W_END <= 43 * MiB, "weights region");
constexpr size_t S_BASE = 43 * MiB;
constexpr size_t S_MOD = S_BASE;
constexpr size_t S_MODP = S_MOD + (size_t)2 * 5 * 6144 * 4;
constexpr size_t S_W2 = S_MODP + (size_t)2 * 16 * 5 * 6144 * 4;
constexpr size_t S_HID = S_W2 + (size_t)8192 * 8;
constexpr size_t S_HIDC = S_HID + (size_t)8192 * 64 * 4;
constexpr size_t S_DT = S_HIDC + (size_t)256 * 64 * 4;
constexpr size_t S_CDEC = S_DT + (size_t)ROWS * 16 * 4;
constexpr size_t S_CTR = S_CDEC + (size_t)2 * NB * NCH * 8 * 4;
constexpr size_t S_XCTX = S_CTR + 256;
constexpr size_t S_BAR = S_XCTX + (size_t)NB * CTX * DM * 4;
constexpr size_t S_END = S_BAR + 16384;
static_assert(S_END <= 57 * MiB, "small region");
constexpr size_t H_OFF = 57 * MiB;
constexpr size_t AR = 123 * MiB;
constexpr size_t A_OHY = AR + 356 * MiB, A_OMLA = AR + 323 * MiB, A_DAQ = AR + 290 * MiB;
constexpr size_t A_PTHY = AR, A_GSPEC = AR + 99 * MiB, A_ZSAVE = AR + 227 * MiB, A_YSAVE = AR + 259 * MiB;
constexpr size_t A_MLAQ = AR, A_DAK = AR + 99 * MiB / 2, A_DAVT = A_DAK + 33 * MiB, A_MLAC = A_DAVT + 33 * MiB;
constexpr size_t A_MLAKN = A_MLAC + 46 * MiB, A_MLAVT = A_MLAKN + 33 * MiB;
static_assert(A_MLAVT + 33 * MiB <= A_DAQ, "round A");
constexpr size_t A_SSDZX = AR, A_STF = AR + 99 * MiB, A_STB = A_STF + 66 * MiB, A_YBUF = A_STB + 66 * MiB;
constexpr size_t A_XSACT = AR + 132 * MiB, A_BCACT = AR + 198 * MiB;
constexpr size_t A_MIXED = AR + 99 * MiB, A_YOUT = A_MIXED + 66 * MiB;
constexpr size_t A_ACT = AR, A_F = AR + 182 * MiB;
constexpr size_t WS_NEED = 512 * MiB;

constexpr int LDS_BYTES = 73728;

DI int get_tid() { int t = threadIdx.x; asm volatile("" : "+v"(t)); return t; }
DI int get_bid() { int t = blockIdx.x; asm volatile("" : "+s"(t)); return t; }
typedef __attribute__((ext_vector_type(2))) __bf16 B2;
DI u16 f2bf(float x) { __bf16 b = (__bf16)x; return __builtin_bit_cast(u16, b); }
DI float bf2f(u16 h) { return __uint_as_float(((unsigned)h) << 16); }
DI unsigned pack2(float a, float b) { F2 v = {a, b}; B2 r = __builtin_convertvector(v, B2); return __builtin_bit_cast(unsigned, r); }
DI float lo2f(unsigned v) { return __uint_as_float(v << 16); }
DI float hi2f(unsigned v) { return __uint_as_float(v & 0xffff0000u); }
DI void unpack8(const U4& v, float (&x)[8]) {
  x[0] = lo2f(v.x); x[1] = hi2f(v.x); x[2] = lo2f(v.y); x[3] = hi2f(v.y);
  x[4] = lo2f(v.z); x[5] = hi2f(v.z); x[6] = lo2f(v.w); x[7] = hi2f(v.w);
}
DI U4 pack8(const float (&x)[8]) { return mku4(pack2(x[0], x[1]), pack2(x[2], x[3]), pack2(x[4], x[5]), pack2(x[6], x[7])); }
DI float wave_sum(float v) { for (int o = 32; o > 0; o >>= 1) v += __shfl_xor(v, o); return v; }
DI float siluf(float x) { return x / (1.f + __expf(-x)); }
DI float sigmoidf(float x) { return 1.f / (1.f + __expf(-x)); }
DI float fexp2(float x) { return __builtin_amdgcn_exp2f(x); }
DI int crow(int t, int h) { return (t & 3) + 8 * (t >> 2) + 4 * h; }
DI f32x16 zero16() { f32x16 z; for (int i = 0; i < 16; ++i) z[i] = 0.f; return z; }

DI const float* xrow_in(PP p, int r, bool first) {
  int b = r / TT, t = r - b * TT;
  if (first) return t < CTX ? p->in[I_CTX] + ((size_t)b * CTX + t) * DM : p->in[I_X] + ((size_t)b * SEQ + (t - CTX)) * DM;
  return t < CTX ? (const float*)(p->ws + S_XCTX) + ((size_t)b * CTX + t) * DM : p->out + ((size_t)b * SEQ + (t - CTX)) * DM;
}
DI float* xrow_out(PP p, int r) {
  int b = r / TT, t = r - b * TT;
  return t < CTX ? (float*)(p->ws + S_XCTX) + ((size_t)b * CTX + t) * DM : p->out + ((size_t)b * SEQ + (t - CTX)) * DM;
}
DI const float* modvec(PP p, int l, int s, int idx) { return (const float*)(p->ws + S_MOD) + ((size_t)(l * 5 + s) * 6 + idx) * DM; }

constexpr int GL = 72;
template <int MT, bool SWAP = true>
DI void gemm_acc(f32x16 (&acc)[MT][2], const u16* __restrict__ A, int lda, const u16* __restrict__ Bt, int ldb, int K, u16* lds) {
  const int tid = get_tid(), lane = tid & 63, w = tid >> 6, wm = w >> 1, wn = w & 1, r = lane & 31, h = lane >> 5;
  constexpr int STG = 256 * GL;
  U4 ra[2 * MT], rb[4];
  const int lrow = tid >> 3, lkc = (tid & 7) * 8;
  const u16* Ap = A + (size_t)lrow * lda + lkc; const u16* Bp = Bt + (size_t)lrow * ldb + lkc;
  const unsigned a32 = 32u * (unsigned)lda, b32 = 32u * (unsigned)ldb;
#pragma unroll
  for (int i = 0; i < 2 * MT; ++i) ra[i] = *(const U4*)(Ap + i * a32);
#pragma unroll
  for (int i = 0; i < 4; ++i) rb[i] = *(const U4*)(Bp + i * b32);
  __syncthreads();
  {
    u16* As = lds; u16* Bs = lds + 128 * GL;
#pragma unroll
    for (int i = 0; i < 2 * MT; ++i) *(U4*)(As + (lrow + 32 * i) * GL + lkc) = ra[i];
#pragma unroll
    for (int i = 0; i < 4; ++i) *(U4*)(Bs + (lrow + 32 * i) * GL + lkc) = rb[i];
  }
  if (K > 64) {
#pragma unroll
    for (int i = 0; i < 2 * MT; ++i) ra[i] = *(const U4*)(Ap + 64 + i * a32);
#pragma unroll
    for (int i = 0; i < 4; ++i) rb[i] = *(const U4*)(Bp + 64 + i * b32);
  }
  __syncthreads();
  const int KT = K >> 6;
  for (int kt = 0; kt < KT; ++kt) {
    const u16* As = lds + (kt & 1) * STG; const u16* Bs = As + 128 * GL;
    if (kt + 1 < KT) {
      u16* An = lds + ((kt + 1) & 1) * STG; u16* Bn = An + 128 * GL;
#pragma unroll
      for (int i = 0; i < 2 * MT; ++i) *(U4*)(An + (lrow + 32 * i) * GL + lkc) = ra[i];
#pragma unroll
      for (int i = 0; i < 4; ++i) *(U4*)(Bn + (lrow + 32 * i) * GL + lkc) = rb[i];
      if (kt + 2 < KT) {
        const int ko = (kt + 2) * 64;
#pragma unroll
        for (int i = 0; i < 2 * MT; ++i) ra[i] = *(const U4*)(Ap + ko + i * a32);
#pragma unroll
        for (int i = 0; i < 4; ++i) rb[i] = *(const U4*)(Bp + ko + i * b32);
      }
    }
#pragma unroll
    for (int ks = 0; ks < 4; ++ks) {
      bf16x8 a[MT], b[2];
#pragma unroll
      for (int i = 0; i < MT; ++i) a[i] = *(const bf16x8*)(As + (wm * 32 * MT + i * 32 + r) * GL + ks * 16 + h * 8);
#pragma unroll
      for (int j = 0; j < 2; ++j) b[j] = *(const bf16x8*)(Bs + (wn * 64 + j * 32 + r) * GL + ks * 16 + h * 8);
#pragma unroll
      for (int i = 0; i < MT; ++i)
#pragma unroll
        for (int j = 0; j < 2; ++j) acc[i][j] = SWAP ? MFMA(b[j], a[i], acc[i][j]) : MFMA(a[i], b[j], acc[i][j]);
    }
    __syncthreads();
  }
}
template <int MT> DI void zero_acc(f32x16 (&acc)[MT][2]) { for (int i = 0; i < MT; ++i) for (int j = 0; j < 2; ++j) acc[i][j] = zero16(); }

template <int MT, int NT>
DI void wave_mma(f32x16 (&acc)[MT][NT], const u16* A, int lda, const u16* Bt, int ldb, int K) {
  const int lane = get_tid() & 63, r = lane & 31, h = lane >> 5;
  for (int k = 0; k < K; k += 16) {
    bf16x8 a[MT], b[NT];
#pragma unroll
    for (int i = 0; i < MT; ++i) a[i] = *(const bf16x8*)(A + (i * 32 + r) * lda + k + h * 8);
#pragma unroll
    for (int j = 0; j < NT; ++j) b[j] = *(const bf16x8*)(Bt + (j * 32 + r) * ldb + k + h * 8);
#pragma unroll
    for (int i = 0; i < MT; ++i)
#pragma unroll
      for (int j = 0; j < NT; ++j) acc[i][j] = MFMA(a[i], b[j], acc[i][j]);
  }
}

template <int MT>
DI void store_tile_bf16(const f32x16 (&acc)[MT][2], u16* dst, size_t ldc, int row0, int col0, int ncols) {
  const int lane = get_tid() & 63, w = get_tid() >> 6, wm = w >> 1, wn = w & 1, r = lane & 31, h = lane >> 5;
#pragma unroll
  for (int i = 0; i < MT; ++i) {
    u16* rowp = dst + (size_t)(row0 + wm * 32 * MT + i * 32 + r) * ldc;
#pragma unroll
    for (int j = 0; j < 2; ++j)
#pragma unroll
      for (int g = 0; g < 4; ++g) {
        int col = col0 + wn * 64 + j * 32 + 8 * g + 4 * h;
        if (col < ncols) *(U2*)(rowp + col) = mku2(pack2(acc[i][j][4 * g], acc[i][j][4 * g + 1]), pack2(acc[i][j][4 * g + 2], acc[i][j][4 * g + 3]));
      }
  }
}
DI void store_tile_f32(const f32x16 (&acc)[2][2], float* dst, size_t ldc, int row0, int col0, int ncols) {
  const int lane = get_tid() & 63, w = get_tid() >> 6, wm = w >> 1, wn = w & 1, r = lane & 31, h = lane >> 5;
#pragma unroll
  for (int i = 0; i < 2; ++i) {
    float* rowp = dst + (size_t)(row0 + wm * 64 + i * 32 + r) * ldc;
#pragma unroll
    for (int j = 0; j < 2; ++j)
#pragma unroll
      for (int g = 0; g < 4; ++g) {
        int col = col0 + wn * 64 + j * 32 + 8 * g + 4 * h;
        if (col < ncols) *(F4*)(rowp + col) = mkf4(acc[i][j][4 * g], acc[i][j][4 * g + 1], acc[i][j][4 * g + 2], acc[i][j][4 * g + 3]);
      }
  }
}
DI void store_tile_T(const f32x16 (&acc)[2][2], u16* dstT, int ncolsT, int row0, int col0) {
  const int lane = get_tid() & 63, w = get_tid() >> 6, wm = w >> 1, wn = w & 1, r = lane & 31, h = lane >> 5;
  const int b = row0 / TT, t0 = row0 - b * TT;
#pragma unroll
  for (int i = 0; i < 2; ++i)
#pragma unroll
    for (int j = 0; j < 2; ++j) {
      int col = col0 + wn * 64 + j * 32 + r;
      u16* base = dstT + ((size_t)b * ncolsT + col) * TT + t0 + wm * 64 + i * 32 + 4 * h;
#pragma unroll
      for (int g = 0; g < 4; ++g) {
        U2 v = mku2(pack2(acc[i][j][4 * g], acc[i][j][4 * g + 1]), pack2(acc[i][j][4 * g + 2], acc[i][j][4 * g + 3]));
        *(U2*)(base + 8 * g) = v;
      }
    }
}

struct TileIter { int off; };
#define FOR_TILES(IT, NT_, VAR) for (int VAR = (int)(((long)get_bid() - (IT).off % (int)gridDim.x + gridDim.x) % gridDim.x); VAR < (NT_); VAR += gridDim.x)

DI void conv_job(TileIter& it, const float* src, int K, int N, u16* dst, float* tile  ) {
  const int tid = get_tid();
  const int nkt = K / 64, nnt = (N + 63) / 64, ntile = nkt * nnt;
  FOR_TILES(it, ntile, ti) {
    int kt = ti % nkt, nt = ti / nkt;
    __syncthreads();
#pragma unroll
    for (int i = 0; i < 4; ++i) {
      int kr = (tid >> 4) + 16 * i, nc = (tid & 15) * 4;
      int n = nt * 64 + nc;
      F4 v = mkf4(0.f, 0.f, 0.f, 0.f);
      if (n < N) v = *(const F4*)(src + (size_t)(kt * 64 + kr) * N + n);
      tile[kr * 65 + nc] = v.x; tile[kr * 65 + nc + 1] = v.y; tile[kr * 65 + nc + 2] = v.z; tile[kr * 65 + nc + 3] = v.w;
    }
    __syncthreads();
    int nl = tid >> 2, kc = (tid & 3) * 16;
    int n = nt * 64 + nl;
    if (n < N) {
      float x[8];
#pragma unroll
      for (int hlf = 0; hlf < 2; ++hlf) {
#pragma unroll
        for (int e = 0; e < 8; ++e) x[e] = tile[(kc + hlf * 8 + e) * 65 + nl];
        *(U4*)(dst + (size_t)n * K + kt * 64 + kc + hlf * 8) = pack8(x);
      }
    }
  }
  it.off += ntile;
}

DI void phase_conv(PP p, int l, unsigned char* lds) {
  float* tile = (float*)lds;
  unsigned char* ws = p->ws;
  TileIter it{0};
  conv_job(it, p->in[I_WIN] + (size_t)l * DM * IN_COLS, DM, IN_COLS, (u16*)(ws + W_WIN), tile);
  conv_job(it, p->in[I_WUQ] + (size_t)l * 384 * 768, 384, 768, (u16*)(ws + W_UQ), tile);
  conv_job(it, p->in[I_WUKV] + (size_t)l * 256 * 1024, 256, 1024, (u16*)(ws + W_UKV), tile);
  for (int i = 0; i < 4; ++i) conv_job(it, p->in[I_WBDA + i] + (size_t)l * 512 * 1024, 512, 1024, (u16*)(ws + W_BR) + (size_t)i * 1024 * 512, tile);
  conv_job(it, p->in[I_WOUT] + (size_t)l * DM * DM, DM, DM, (u16*)(ws + W_OUT), tile);
  conv_job(it, p->in[I_W1] + (size_t)l * DM * FFN, DM, FFN, (u16*)(ws + W_F1), tile);
  conv_job(it, p->in[I_W3] + (size_t)l * DM * FFN, DM, FFN, (u16*)(ws + W_F3), tile);
  conv_job(it, p->in[I_W2] + (size_t)l * FFN * DM, FFN, DM, (u16*)(ws + W_F2), tile);
  const int tid = get_tid();
  if (get_bid() == 0 && tid < 64) ((int*)(ws + S_CTR))[tid] = 0;
  if (l == 0) {
    F2* W2 = (F2*)(ws + S_W2);
    for (int m = get_bid() * 256 + tid; m < 8192; m += gridDim.x * 256) {
      float sn, cs; sincospif((float)m * (1.f / 8192.f), &sn, &cs);
      W2[m] = mkf2(cs, -sn);
    }
    float* modp = (float*)(ws + S_MODP);
    for (int itx = get_bid(); itx < 2 * 24 * 16; itx += gridDim.x) {
      int l2 = itx / 384, rem = itx % 384, cb = rem / 16, ks = rem % 16;
      int col = cb * 256 + tid;
      const float* mw = p->in[I_MODW] + (size_t)l2 * DM * 6144;
      float acc[5] = {0.f, 0.f, 0.f, 0.f, 0.f};
#pragma unroll 4
      for (int k = ks * 64; k < ks * 64 + 64; ++k) {
        float wv = mw[(size_t)k * 6144 + col];
#pragma unroll
        for (int s = 0; s < 5; ++s) { float cv = (s < 4) ? p->in[I_C][s * DM + k] : p->in[I_CCTX][k]; acc[s] += siluf(cv) * wv; }
      }
#pragma unroll
      for (int s = 0; s < 5; ++s) modp[(((size_t)l2 * 16 + ks) * 5 + s) * 6144 + col] = acc[s];
    }
  }
  {
    __syncthreads();
    float* feats = (float*)lds;
    float* h1 = feats + 4 * 36;
    const float* w1 = p->in[I_HW1] + (size_t)l * 33 * 64; const float* b1 = p->in[I_HB1] + l * 64; const float* f1 = p->in[I_HF1] + l * 64;
    const float* w2 = p->in[I_HW2] + (size_t)l * 64 * 64; const float* b2 = p->in[I_HB2] + l * 64; const float* f2 = p->in[I_HF2] + l * 64;
    const int nitem = 2048 + (l == 0 ? 64 : 0);
    for (int itx = get_bid(); itx < nitem; itx += gridDim.x) {
      const bool isc = itx >= 2048;
      const int n = isc ? 256 : 8192;
      const int tl = tid >> 6, j = tid & 63;
      const int t = (isc ? (itx - 2048) : itx) * 4 + tl;
      __syncthreads();
      if (j < 33) {
        float f;
        if (j == 0) f = (float)t / (float)(n - 1);
        else {
          int bi = (j - 1) & 15;
          float band = 1e-4f + (float)bi * ((15.0f - 1e-4f) / 15.0f);
          float xx = 2.f * ((float)t / (float)n) * band;
          float sn, cs; sincospif(xx, &sn, &cs);
          f = (j <= 16) ? cs : -sn;
        }
        feats[tl * 36 + j] = f;
      }
      __syncthreads();
      float a = b1[j];
#pragma unroll 3
      for (int i = 0; i < 33; ++i) a += feats[tl * 36 + i] * w1[i * 64 + j];
      h1[tl * 64 + j] = sinf(f1[j] * a);
      __syncthreads();
      float a2 = b2[j];
#pragma unroll 4
      for (int k = 0; k < 64; ++k) a2 += h1[tl * 64 + k] * w2[k * 64 + j];
      const float hv2 = sinf(f2[j] * a2);
      if (isc) ((float*)(ws + S_HIDC))[(size_t)t * 64 + j] = hv2; else ((u16*)(ws + S_HID))[(size_t)t * 64 + j] = f2bf(hv2);
    }
  }
}

DI void phase_modfin(PP p) {
  float* mod = (float*)(p->ws + S_MOD); const float* modp = (const float*)(p->ws + S_MODP);
  for (int i = get_bid() * 256 + get_tid(); i < 2 * 5 * 6144; i += gridDim.x * 256) {
    int l2 = i / (5 * 6144), rem = i % (5 * 6144), s = rem / 6144, col = rem % 6144;
    float a = p->in[I_MODB][l2 * 6144 + col];
#pragma unroll 4
    for (int ks = 0; ks < 16; ++ks) a += modp[(((size_t)l2 * 16 + ks) * 5 + s) * 6144 + col];
    mod[((size_t)(l2 * 5 + s)) * 6144 + col] = a;
  }
}

DI void phase_rowwise(PP p, bool first, const u16* src, const float* g_post, int l_res, int gate_idx,
                      bool write_h, const float* g_pre, int l_mod, int shift_idx, int scale_idx, bool skip_ctx) {
  const int lane = get_tid() & 63, w = get_tid() >> 6;
  u16* H = (u16*)(p->ws + H_OFF);
  for (int r = get_bid() * 4 + w; r < ROWS; r += gridDim.x * 4) {
    int b = r / TT, t = r - b * TT;
    if (skip_ctx && t < CTX) continue;
    int s = t < CTX ? 4 : b;
    const float* xin = xrow_in(p, r, first);
    float x[16];
#pragma unroll
    for (int i = 0; i < 4; ++i) { F4 v = *(const F4*)(xin + i * 256 + lane * 4); x[4 * i] = v.x; x[4 * i + 1] = v.y; x[4 * i + 2] = v.z; x[4 * i + 3] = v.w; }
    if (src) {
      float y[16]; float ss = 0.f;
#pragma unroll
      for (int i = 0; i < 4; ++i) { U2 v = *(const U2*)(src + (size_t)r * DM + i * 256 + lane * 4);
        y[4 * i] = lo2f(v.x); y[4 * i + 1] = hi2f(v.x); y[4 * i + 2] = lo2f(v.y); y[4 * i + 3] = hi2f(v.y); }
#pragma unroll
      for (int i = 0; i < 16; ++i) ss += y[i] * y[i];
      ss = wave_sum(ss);
      float rstd = rsqrtf(ss * (1.f / DM) + EPS);
      const float* gate = modvec(p, l_res, s, gate_idx);
      float* xo = xrow_out(p, r);
#pragma unroll
      for (int i = 0; i < 4; ++i) {
        int k = i * 256 + lane * 4;
        F4 g = *(const F4*)(g_post + k); F4 gt = *(const F4*)(gate + k);
        x[4 * i] += gt.x * (y[4 * i] * rstd * g.x); x[4 * i + 1] += gt.y * (y[4 * i + 1] * rstd * g.y);
        x[4 * i + 2] += gt.z * (y[4 * i + 2] * rstd * g.z); x[4 * i + 3] += gt.w * (y[4 * i + 3] * rstd * g.w);
        *(F4*)(xo + k) = mkf4(x[4 * i], x[4 * i + 1], x[4 * i + 2], x[4 * i + 3]);
      }
    }
    if (write_h) {
      float ss = 0.f;
#pragma unroll
      for (int i = 0; i < 16; ++i) ss += x[i] * x[i];
      ss = wave_sum(ss);
      float rstd = rsqrtf(ss * (1.f / DM) + EPS);
      const float* sh = modvec(p, l_mod, s, shift_idx); const float* sc = modvec(p, l_mod, s, scale_idx);
#pragma unroll
      for (int i = 0; i < 4; ++i) {
        int k = i * 256 + lane * 4;
        F4 g = *(const F4*)(g_pre + k); F4 a = *(const F4*)(sh + k); F4 c = *(const F4*)(sc + k);
        float h0 = x[4 * i] * rstd * g.x * (1.f + c.x) + a.x, h1 = x[4 * i + 1] * rstd * g.y * (1.f + c.y) + a.y;
        float h2 = x[4 * i + 2] * rstd * g.z * (1.f + c.z) + a.z, h3 = x[4 * i + 3] * rstd * g.w * (1.f + c.w) + a.w;
        *(U2*)(H + (size_t)r * DM + k) = mku2(pack2(h0, h1), pack2(h2, h3));
      }
    }
  }
}

DI void gemm_job(TileIter& it, const u16* A, int lda, const u16* Bt, int ldb, int K, int N, int mode, void* dst, int ldc, u16* lds, bool skipc = false) {
  const int ntn = (N + 127) / 128, ntile = (skipc ? NB * 64 : ROWS / 128) * ntn;
  FOR_TILES(it, ntile, ti) {
    int tm = ti / ntn, tn = ti % ntn;
    if (skipc) tm = NCH * (tm >> 6) + 2 + (tm & 63);
    f32x16 acc[2][2]; zero_acc<2>(acc);
    if (mode == 2) {
      gemm_acc<2, false>(acc, A + (size_t)tm * 128 * lda, lda, Bt + (size_t)tn * 128 * ldb, ldb, K, lds);
      store_tile_T(acc, (u16*)dst, N, tm * 128, tn * 128);
    } else {
      gemm_acc<2, true>(acc, A + (size_t)tm * 128 * lda, lda, Bt + (size_t)tn * 128 * ldb, ldb, K, lds);
      if (mode == 0) store_tile_bf16<2>(acc, (u16*)dst, ldc, tm * 128, tn * 128, N);
      else store_tile_f32(acc, (float*)dst, ldc, tm * 128, tn * 128, N);
    }
  }
  it.off += ntile;
}

DI void phase_rope(PP p, int l) {
  const int lane = get_tid() & 63, w = get_tid() >> 6;
  u16* daq = (u16*)(p->ws + A_DAQ); u16* dak = (u16*)(p->ws + A_DAK); u16* mc = (u16*)(p->ws + A_MLAC);
  const float* qn = p->in[I_MQN] + l * 384; const float* kvn = p->in[I_MKVN] + l * 256;
  const float L2_10000 = 13.287712379549449f;
  for (int r = get_bid() * 4 + w; r < ROWS; r += gridDim.x * 4) {
    int b = r / TT, t = r - b * TT;
    const bool lat = t >= CTX;
    const int pos = t - CTX; const float prow = (float)(pos >> 6), pcol = (float)(pos & 63);
    if (lat) {
      int v = lane >> 3, i0 = (lane & 7) * 4;
      float cs[4], sn[4];
#pragma unroll
      for (int e = 0; e < 4; ++e) { int i = i0 + e; float inv = exp2f(-(float)(i & 15) * (1.f / 16.f) * L2_10000); float ang = (i < 16 ? prow : pcol) * inv; sincosf(ang, &sn[e], &cs[e]); }
#pragma unroll
      for (int which = 0; which < 2; ++which) {
        u16* base = (which ? dak : daq) + (size_t)r * 512 + v * 64 + i0;
        U2 a = *(U2*)base, c = *(U2*)(base + 32);
        float x1[4] = {lo2f(a.x), hi2f(a.x), lo2f(a.y), hi2f(a.y)}, x2[4] = {lo2f(c.x), hi2f(c.x), lo2f(c.y), hi2f(c.y)};
        float o1[4], o2[4];
#pragma unroll
        for (int e = 0; e < 4; ++e) { o1[e] = x1[e] * cs[e] - x2[e] * sn[e]; o2[e] = x2[e] * cs[e] + x1[e] * sn[e]; }
        *(U2*)base = mku2(pack2(o1[0], o1[1]), pack2(o1[2], o1[3]));
        *(U2*)(base + 32) = mku2(pack2(o2[0], o2[1]), pack2(o2[2], o2[3]));
      }
    }
    u16* row = mc + (size_t)r * 704;
    {
      float x[6]; float ss = 0.f;
#pragma unroll
      for (int i = 0; i < 3; ++i) { unsigned v = *(unsigned*)(row + i * 128 + lane * 2); x[2 * i] = lo2f(v); x[2 * i + 1] = hi2f(v); }
#pragma unroll
      for (int i = 0; i < 6; ++i) ss += x[i] * x[i];
      ss = wave_sum(ss); float rstd = rsqrtf(ss * (1.f / 384.f) + EPS);
#pragma unroll
      for (int i = 0; i < 3; ++i) { int k = i * 128 + lane * 2; *(unsigned*)(row + k) = pack2(x[2 * i] * rstd * qn[k], x[2 * i + 1] * rstd * qn[k + 1]); }
    }
    {
      float x[4]; float ss = 0.f;
#pragma unroll
      for (int i = 0; i < 2; ++i) { unsigned v = *(unsigned*)(row + 384 + i * 128 + lane * 2); x[2 * i] = lo2f(v); x[2 * i + 1] = hi2f(v); }
#pragma unroll
      for (int i = 0; i < 4; ++i) ss += x[i] * x[i];
      ss = wave_sum(ss); float rstd = rsqrtf(ss * (1.f / 256.f) + EPS);
#pragma unroll
      for (int i = 0; i < 2; ++i) { int k = i * 128 + lane * 2; *(unsigned*)(row + 384 + k) = pack2(x[2 * i] * rstd * kvn[k], x[2 * i + 1] * rstd * kvn[k + 1]); }
    }
    if (lat && lane < 32) {
      int i = lane; float inv = exp2f(-(float)(i & 15) * (1.f / 16.f) * L2_10000); float ang = (i < 16 ? prow : pcol) * inv; float sn, cs; sincosf(ang, &sn, &cs);
      float x1 = bf2f(row[640 + i]), x2 = bf2f(row[640 + 32 + i]);
      row[640 + i] = f2bf(x1 * cs - x2 * sn); row[640 + 32 + i] = f2bf(x2 * cs + x1 * sn);
    }
  }
}

template <int DQK>
struct AttnState { f32x16 ot[4]; float m, l; };

template <int DQK, int QR>
DI void attn_tile(AttnState<DQK>& st, const bf16x8 (&q)[QR], const u16* qlds, const u16* Ks, int kcol0, const u16* Vs) {
  constexpr int KL = (DQK == 64 ? 128 : 192) + 8;
  const int lane = get_tid() & 63, r = lane & 31, h = lane >> 5;
#pragma unroll
  for (int kb = 0; kb < 2; ++kb) {
    f32x16 s = zero16();
#pragma unroll
    for (int ks = 0; ks < DQK / 16; ++ks) {
      bf16x8 a = *(const bf16x8*)(Ks + (kb * 32 + r) * KL + kcol0 + ks * 16 + h * 8);
      bf16x8 qv;
      if (ks < QR) qv = q[ks < QR ? ks : 0]; else qv = *(const bf16x8*)(qlds + (ks - QR) * 16);
      s = MFMA(a, qv, s);
    }
    if (DQK == 192) __builtin_amdgcn_sched_barrier(0);
    float mx = s[0];
#pragma unroll
    for (int t = 1; t < 16; ++t) mx = fmaxf(mx, s[t]);
    mx = fmaxf(mx, __shfl_xor(mx, 32));
    const float mnew = fmaxf(st.m, mx);
    const float alpha = fexp2(st.m - mnew);
    st.m = mnew;
    float ps = 0.f;
#pragma unroll
    for (int t = 0; t < 16; ++t) { float pv = fexp2(s[t] - mnew); s[t] = pv; ps += pv; }
    st.l = st.l * alpha + ps;
    if (__builtin_amdgcn_ballot_w64(alpha != 1.f) != 0) {
#pragma unroll
      for (int eb = 0; eb < 4; ++eb)
#pragma unroll
        for (int t = 0; t < 16; ++t) st.ot[eb][t] *= alpha;
    }
#pragma unroll
    for (int s2 = 0; s2 < 2; ++s2) {
      unsigned pk[4];
#pragma unroll
      for (int j = 0; j < 4; ++j) pk[j] = pack2(s[8 * s2 + 2 * j], s[8 * s2 + 2 * j + 1]);
      bf16x8 pf = __builtin_bit_cast(bf16x8, mku4(pk[0], pk[1], pk[2], pk[3]));
#pragma unroll
      for (int eb = 0; eb < 4; ++eb) {
        const u16* vp = Vs + (eb * 32 + r) * 72 + kb * 32 + 16 * s2 + 4 * h;
        U2 lo = *(const U2*)vp, hi = *(const U2*)(vp + 8);
        bf16x8 vf = __builtin_bit_cast(bf16x8, mku4(lo.x, lo.y, hi.x, hi.y));
        st.ot[eb] = MFMA(vf, pf, st.ot[eb]);
      }
    }
    if (DQK == 192) __builtin_amdgcn_sched_barrier(0);
  }
}

template <int DQK, int QR>
DI void attn_tile64(AttnState<DQK>& st, const bf16x8 (&q)[QR], const u16* Ks, int kcol0, const u16* Vs) {
  constexpr int KL = (DQK == 64 ? 128 : 192) + 8;
  const int lane = get_tid() & 63, r = lane & 31, h = lane >> 5;
  f32x16 s[2];
#pragma unroll
  for (int kb = 0; kb < 2; ++kb) {
    s[kb] = zero16();
#pragma unroll
    for (int ks = 0; ks < DQK / 16; ++ks) {
      bf16x8 a = *(const bf16x8*)(Ks + (kb * 32 + r) * KL + kcol0 + ks * 16 + h * 8);
      s[kb] = MFMA(a, q[ks], s[kb]);
    }
  }
  float mx = s[0][0];
#pragma unroll
  for (int kb = 0; kb < 2; ++kb)
#pragma unroll
    for (int t = 0; t < 16; ++t) mx = fmaxf(mx, s[kb][t]);
  mx = fmaxf(mx, __shfl_xor(mx, 32));
  const float mnew = fmaxf(st.m, mx);
  const float alpha = fexp2(st.m - mnew);
  st.m = mnew;
  float ps = 0.f;
#pragma unroll
  for (int kb = 0; kb < 2; ++kb)
#pragma unroll
    for (int t = 0; t < 16; ++t) { float pv = fexp2(s[kb][t] - mnew); s[kb][t] = pv; ps += pv; }
  st.l = st.l * alpha + ps;
  if (__builtin_amdgcn_ballot_w64(alpha != 1.f) != 0) {
#pragma unroll
    for (int eb = 0; eb < 4; ++eb)
#pragma unroll
      for (int t = 0; t < 16; ++t) st.ot[eb][t] *= alpha;
  }
#pragma unroll
  for (int kb = 0; kb < 2; ++kb)
#pragma unroll
    for (int s2 = 0; s2 < 2; ++s2) {
      unsigned pk[4];
#pragma unroll
      for (int j = 0; j < 4; ++j) pk[j] = pack2(s[kb][8 * s2 + 2 * j], s[kb][8 * s2 + 2 * j + 1]);
      bf16x8 pf = __builtin_bit_cast(bf16x8, mku4(pk[0], pk[1], pk[2], pk[3]));
#pragma unroll
      for (int eb = 0; eb < 4; ++eb) {
        const u16* vp = Vs + (eb * 32 + r) * 72 + kb * 32 + 16 * s2 + 4 * h;
        U2 lo = *(const U2*)vp, hi = *(const U2*)(vp + 8);
        bf16x8 vf = __builtin_bit_cast(bf16x8, mku4(lo.x, lo.y, hi.x, hi.y));
        st.ot[eb] = MFMA(vf, pf, st.ot[eb]);
      }
    }
}

DI void phase_attn(PP p, int l, bool need_ctx, unsigned char* ldsb, int probe = 0) {
  const int tid = get_tid(), lane = tid & 63, w = tid >> 6, r = lane & 31, h = lane >> 5;
  unsigned char* ws = p->ws;
  const u16* mlaq = (const u16*)(ws + A_MLAQ); const u16* mlakn = (const u16*)(ws + A_MLAKN); const u16* mlavt = (const u16*)(ws + A_MLAVT);
  const u16* mlac = (const u16*)(ws + A_MLAC); u16* omla = (u16*)(ws + A_OMLA);
  u16* daq = (u16*)(ws + A_DAQ); const u16* dak = (const u16*)(ws + A_DAK); const u16* davt = (const u16*)(ws + A_DAVT);
  const float L2E = 1.4426950408889634f, L2_10000 = 13.287712379549449f;
  const int n_mla = NB * 66 * 4, n_da = NB * 132 * 4;
  int* ctr = (int*)(ws + S_CTR);
  int* sh_item = (int*)(ldsb + 72704);
  const int grp = get_bid() & 7;
  const int n_items = probe ? 128 : 384 + (need_ctx ? 12 : 0);
  for (;;) {
    __syncthreads();
    if (tid == 0) *sh_item = atomicAdd(ctr + grp + (probe ? 8 : 0), 1);
    __syncthreads();
    const int qi = *sh_item;
    if (qi >= n_items) break;
    int item;
    if (qi < 128) { int pr = grp + 8 * (qi >> 6), qb = 2 + (qi & 63); item = (pr >> 2) * 264 + qb * 4 + (pr & 3); }
    else if (qi < 384) { int q2 = qi - 128; int pr = grp + 8 * (q2 >> 7), qb = 4 + (q2 & 127); item = n_mla + (pr >> 2) * 528 + qb * 4 + (pr & 3); }
    else if (qi < 388) { int q2 = qi - 384; int pr = grp + 8 * (q2 >> 1), qb = q2 & 1; item = (pr >> 2) * 264 + qb * 4 + (pr & 3); }
    else { int q2 = qi - 388; int pr = grp + 8 * (q2 >> 2), qb = q2 & 3; item = n_mla + (pr >> 2) * 528 + qb * 4 + (pr & 3); }
    if (item < n_mla) {
      const int b = item / 264, rem = item % 264, qb = rem >> 2, hd = rem & 3;
      const int nk = qb < 2 ? CTX : TT;
      constexpr int KL = 200;
      u16* Ks = (u16*)ldsb; u16* Vs = Ks + 64 * KL;
      const int tq = qb * 128 + w * 32 + r; const size_t qrow = (size_t)b * TT + tq;
      bf16x8 q[12];
      const u16* qlds = nullptr;
      {
        const float sc = 0.07216878364870323f * L2E;
        const u16* qp = mlaq + qrow * 768 + hd * 192 + h * 8;
#pragma unroll
        for (int ks = 0; ks < 8; ++ks) { U4 v = *(const U4*)(qp + ks * 16); float tmp[8]; unpack8(v, tmp);
#pragma unroll
          for (int j = 0; j < 8; ++j) tmp[j] *= sc;
          q[ks] = __builtin_bit_cast(bf16x8, pack8(tmp)); }
        const bool lat = tq >= CTX;
        const int pos = tq - CTX; const float prow = (float)(pos >> 6), pcol = (float)(pos & 63);
#pragma unroll
        for (int ks = 8; ks < 10; ++ks) {
          U4 v1 = *(const U4*)(qp + ks * 16), v2 = *(const U4*)(qp + (ks + 2) * 16); float x1[8], x2[8]; unpack8(v1, x1); unpack8(v2, x2);
#pragma unroll
          for (int j = 0; j < 8; ++j) {
            int i = (ks - 8) * 16 + h * 8 + j; float inv = exp2f(-(float)(i & 15) * (1.f / 16.f) * L2_10000); float ang = (i < 16 ? prow : pcol) * inv;
            float sn = lat ? __sinf(ang) : 0.f, cs = lat ? __cosf(ang) : 1.f;
            float a = x1[j], c2 = x2[j]; x1[j] = (a * cs - c2 * sn) * sc; x2[j] = (c2 * cs + a * sn) * sc;
          }
          q[ks] = __builtin_bit_cast(bf16x8, pack8(x1)); q[ks + 2] = __builtin_bit_cast(bf16x8, pack8(x2));
        }
      }
      AttnState<192> st; for (int eb = 0; eb < 4; ++eb) st.ot[eb] = zero16(); st.m = -1e30f; st.l = 0.f;
      U4 rk[6], rv[4];
      const u16* kbase = mlakn + ((size_t)b * TT) * 512 + hd * 128; const unsigned koff0 = (unsigned)((tid >> 4) * 512 + (tid & 15) * 8);
      const u16* rbase = mlac + ((size_t)b * TT) * 704 + 640; const unsigned roff0 = (unsigned)((tid >> 3) * 704 + (tid & 7) * 8);
      const u16* vbase = mlavt + ((size_t)b * 512 + hd * 128) * TT; const unsigned voff0 = (unsigned)((tid >> 3) * TT + (tid & 7) * 8);
      auto gl = [&](int k0) {
#pragma unroll
        for (int i = 0; i < 4; ++i) rk[i] = *(const U4*)(kbase + (koff0 + (unsigned)((k0 + 16 * i) * 512)));
#pragma unroll
        for (int i = 0; i < 2; ++i) rk[4 + i] = *(const U4*)(rbase + (roff0 + (unsigned)((k0 + 32 * i) * 704)));
#pragma unroll
        for (int i = 0; i < 4; ++i) rv[i] = *(const U4*)(vbase + (voff0 + (unsigned)(32 * i * TT + k0)));
      };
      for (int k0 = 0; k0 < nk; k0 += 64) {
        gl(k0);
        __syncthreads();
#pragma unroll
        for (int i = 0; i < 4; ++i) { int c = tid + 256 * i, key = c >> 4, kc = c & 15; *(U4*)(Ks + key * KL + kc * 8) = rk[i]; }
#pragma unroll
        for (int i = 0; i < 2; ++i) { int c = tid + 256 * i, key = c >> 3, kc = c & 7; *(U4*)(Ks + key * KL + 128 + kc * 8) = rk[4 + i]; }
#pragma unroll
        for (int i = 0; i < 4; ++i) { int c = tid + 256 * i, e = c >> 3, kc = c & 7; *(U4*)(Vs + e * 72 + kc * 8) = rv[i]; }
        __syncthreads();
        attn_tile64<192, 12>(st, q, Ks, 0, Vs);
      }
      float lt = st.l + __shfl_xor(st.l, 32); float il = 1.f / lt;
#pragma unroll
      for (int eb = 0; eb < 4; ++eb)
#pragma unroll
        for (int g = 0; g < 4; ++g) {
          U2 v = mku2(pack2(st.ot[eb][4 * g] * il, st.ot[eb][4 * g + 1] * il), pack2(st.ot[eb][4 * g + 2] * il, st.ot[eb][4 * g + 3] * il));
          *(U2*)(omla + qrow * 512 + hd * 128 + eb * 32 + 8 * g + 4 * h) = v;
        }
    } else {
      const int it2 = item - n_mla;
      const int b = it2 / 528, rem = it2 % 528, qb = rem >> 2, hd = rem & 3;
      const int nk = qb < 4 ? CTX : TT;
      constexpr int KL = 136;
      u16* Ks = (u16*)ldsb; u16* Vs = Ks + 64 * KL;
      const int comp = w >> 1;
      const int tq = qb * 64 + (w & 1) * 32 + r; const size_t qrow = (size_t)b * TT + tq;
      bf16x8 q[4];
      {
        const float sc = 0.125f * L2E;
#pragma unroll
        for (int ks = 0; ks < 4; ++ks) { U4 v = *(const U4*)(daq + qrow * 512 + hd * 128 + comp * 64 + ks * 16 + h * 8); float tmp[8]; unpack8(v, tmp);
#pragma unroll
          for (int j = 0; j < 8; ++j) tmp[j] *= sc;
          q[ks] = __builtin_bit_cast(bf16x8, pack8(tmp)); }
      }
      AttnState<64> st; for (int eb = 0; eb < 4; ++eb) st.ot[eb] = zero16(); st.m = -1e30f; st.l = 0.f;
      U4 rk[4], rv[4];
      const u16* kbase = dak + ((size_t)b * TT) * 512 + hd * 128; const unsigned koff0 = (unsigned)((tid >> 4) * 512 + (tid & 15) * 8);
      const u16* vbase = davt + ((size_t)b * 512 + hd * 128) * TT; const unsigned voff0 = (unsigned)((tid >> 3) * TT + (tid & 7) * 8);
      auto gl = [&](int k0) {
#pragma unroll
        for (int i = 0; i < 4; ++i) rk[i] = *(const U4*)(kbase + (koff0 + (unsigned)((k0 + 16 * i) * 512)));
#pragma unroll
        for (int i = 0; i < 4; ++i) rv[i] = *(const U4*)(vbase + (voff0 + (unsigned)(32 * i * TT + k0)));
      };
      gl(0);
      for (int k0 = 0; k0 < nk; k0 += 64) {
        __syncthreads();
#pragma unroll
        for (int i = 0; i < 4; ++i) { int c = tid + 256 * i, key = c >> 4, kc = c & 15; *(U4*)(Ks + key * KL + kc * 8) = rk[i]; }
#pragma unroll
        for (int i = 0; i < 4; ++i) { int c = tid + 256 * i, e = c >> 3, kc = c & 7; *(U4*)(Vs + e * 72 + kc * 8) = rv[i]; }
        __syncthreads();
        if (k0 + 64 < nk) gl(k0 + 64);
        attn_tile<64, 4>(st, q, nullptr, Ks, comp * 64, Vs);
      }
      float lt = st.l + __shfl_xor(st.l, 32); float il = 1.f / lt;
      __syncthreads();
      float* O2 = (float*)ldsb;
      const int ql = (w & 1) * 32 + r;
      if (comp == 1) {
#pragma unroll
        for (int eb = 0; eb < 4; ++eb)
#pragma unroll
          for (int t = 0; t < 16; ++t) O2[ql * 132 + eb * 32 + crow(t, h)] = st.ot[eb][t] * il;
      }
      __syncthreads();
      if (comp == 0) {
        const float* lv = p->in[I_DALAM] + l * 256;
        float d1 = 0.f, d2 = 0.f;
#pragma unroll 4
        for (int i = 0; i < 64; ++i) { d1 += lv[i] * lv[64 + i]; d2 += lv[128 + i] * lv[192 + i]; }
        const float lam_init = 0.8f - 0.6f * expf(-0.3f * (float)l);
        const float lam = expf(d1) - expf(d2) + lam_init;
        float ss = 0.f;
#pragma unroll
        for (int eb = 0; eb < 4; ++eb)
#pragma unroll
          for (int t = 0; t < 16; ++t) { float o = st.ot[eb][t] * il - lam * O2[ql * 132 + eb * 32 + crow(t, h)]; st.ot[eb][t] = o; ss += o * o; }
        ss += __shfl_xor(ss, 32);
        const float rs = rsqrtf(ss * (1.f / 128.f) + EPS) * (1.f - lam_init);
        const float* sub = p->in[I_DASUB] + l * 128;
#pragma unroll
        for (int eb = 0; eb < 4; ++eb)
#pragma unroll
          for (int g = 0; g < 4; ++g) {
            int e = eb * 32 + 8 * g + 4 * h;
            U2 v = mku2(pack2(st.ot[eb][4 * g] * rs * sub[e], st.ot[eb][4 * g + 1] * rs * sub[e + 1]),
                                 pack2(st.ot[eb][4 * g + 2] * rs * sub[e + 2], st.ot[eb][4 * g + 3] * rs * sub[e + 3]));
            *(U2*)(daq + qrow * 512 + hd * 128 + e) = v;
          }
      }
    }
  }
}

constexpr int SL = 136;
DI void ssd_conv8(const u16* zx, int row, int lo, int hi, int ch0, const float* cw, const float* cb, float (&out)[8]) {
  F4 b0 = *(const F4*)(cb + ch0), b1 = *(const F4*)(cb + ch0 + 4);
  float acc[8] = {b0.x, b0.y, b0.z, b0.w, b1.x, b1.y, b1.z, b1.w};
#pragma unroll
  for (int k = 0; k < 5; ++k) {
    int rr = row + k - 2;
    if (rr >= lo && rr < hi) {
      U4 v = *(const U4*)(zx + (size_t)rr * 1536 + 512 + ch0); float x[8]; unpack8(v, x);
      F4 w0 = *(const F4*)(cw + k * 1024 + ch0), w1 = *(const F4*)(cw + k * 1024 + ch0 + 4);
      acc[0] += w0.x * x[0]; acc[1] += w0.y * x[1]; acc[2] += w0.z * x[2]; acc[3] += w0.w * x[3];
      acc[4] += w1.x * x[4]; acc[5] += w1.y * x[5]; acc[6] += w1.z * x[6]; acc[7] += w1.w * x[7];
    }
  }
#pragma unroll
  for (int e = 0; e < 8; ++e) out[e] = siluf(acc[e]);
}
DI float softplusf(float x) { return x > 20.f ? x : log1pf(__expf(x)); }
DI float wave_incl_scan(float v) {
  const int lane = get_tid() & 63;
  for (int o = 1; o < 64; o <<= 1) { float u = __shfl_up(v, o); if (lane >= o) v += u; }
  return v;
}

DI void phase_ssdconv(PP p, int l) {
  const u16* zx = (const u16*)(p->ws + A_SSDZX);
  u16* xs = (u16*)(p->ws + A_XSACT); u16* bc = (u16*)(p->ws + A_BCACT);
  const float* cw = p->in[I_SCW] + (size_t)l * 5 * 1024; const float* cb = p->in[I_SCB] + l * 1024;
  const int total = ROWS * 128;
  for (int i = get_bid() * 256 + get_tid(); i < total; i += gridDim.x * 256) {
    const int row = i >> 7, ch0 = (i & 127) * 8;
    const int b = row / TT, t = row - b * TT;
    const int lo = t < CTX ? b * TT : b * TT + CTX, hi = t < CTX ? b * TT + CTX : (b + 1) * TT;
    float v[8];
    ssd_conv8(zx, row, lo, hi, ch0, cw, cb, v);
    u16* dst = ch0 < 512 ? xs + (size_t)row * 512 + ch0 : bc + (size_t)row * 512 + (ch0 - 512);
    *(U4*)dst = pack8(v);
  }
}
DI void ssd_act8(const u16* base, int row, int col, float (&out)[8]) { U4 v = *(const U4*)(base + (size_t)row * 512 + col); unpack8(v, out); }

DI void phase_ssd1(PP p, int l, unsigned char* ldsb) {
  const int tid = get_tid(), lane = tid & 63, w = tid >> 6, r = lane & 31, h = lane >> 5;
  const u16* xsact = (const u16*)(p->ws + A_XSACT); const u16* bcact = (const u16*)(p->ws + A_BCACT); const float* dtraw = (const float*)(p->ws + S_DT);
  float* cdec = (float*)(p->ws + S_CDEC);
  const float* cw = p->in[I_SCW] + (size_t)l * 5 * 1024; const float* cb = p->in[I_SCB] + l * 1024;
  u16* BT = (u16*)ldsb; u16* xT = BT + 128 * SL; float* wts = (float*)(xT + 64 * SL);
  for (int item = get_bid(); item < NB * NCH * 8; item += gridDim.x) {
    const int b = item / (NCH * 8), rem = item % (NCH * 8), c = rem >> 3, head = rem & 7, g = head >> 2;
    const int rows0 = b * TT + c * 128;
    const int lo = c < 2 ? b * TT : b * TT + CTX, hi = c < 2 ? b * TT + CTX : (b + 1) * TT;
    __syncthreads();
    if (w < 2) {
      const int dir = w;
      const float bias = p->in[I_SDTB][l * 16 + dir * 8 + head]; const float Ah = -__expf(p->in[I_SALOG][l * 16 + dir * 8 + head]);
      float d0 = softplusf(dtraw[(size_t)(rows0 + 2 * lane) * 16 + dir * 8 + head] + bias);
      float d1 = softplusf(dtraw[(size_t)(rows0 + 2 * lane + 1) * 16 + dir * 8 + head] + bias);
      float a0 = d0 * Ah, a1 = d1 * Ah;
      float P1 = wave_incl_scan(a0 + a1), P0 = P1 - a1;
      float tot = __shfl(P1, 63);
      if (dir == 0) { wts[2 * lane] = d0 * __expf(tot - P0); wts[2 * lane + 1] = d1 * __expf(tot - P1); }
      else { wts[128 + 2 * lane] = d0 * __expf(P0 - a0); wts[128 + 2 * lane + 1] = d1 * __expf(P1 - a1); }
      if (lane == 0) cdec[((dir * NB + b) * NCH + c) * 8 + head] = __expf(tot);
    }
#pragma unroll
    for (int i = 0; i < 8; ++i) {
      int id = tid + 256 * i, lrow = id >> 4, ch = (id & 15) * 8; float v[8];
      ssd_act8(bcact, rows0 + lrow, g * 128 + ch, v);
#pragma unroll
      for (int e = 0; e < 8; ++e) BT[(ch + e) * SL + lrow] = f2bf(v[e]);
    }
    float xv[4][8];
#pragma unroll
    for (int i = 0; i < 4; ++i) { int id = tid + 256 * i, lrow = id >> 3, ch = (id & 7) * 8; ssd_act8(xsact, rows0 + lrow, head * 64 + ch, xv[i]); }
    for (int dir = 0; dir < 2; ++dir) {
      __syncthreads();
#pragma unroll
      for (int i = 0; i < 4; ++i) { int id = tid + 256 * i, lrow = id >> 3, ch = (id & 7) * 8; float wv = wts[dir * 128 + lrow];
#pragma unroll
        for (int e = 0; e < 8; ++e) xT[(ch + e) * SL + lrow] = f2bf(xv[i][e] * wv); }
      __syncthreads();
      f32x16 acc[2][1]; acc[0][0] = zero16(); acc[1][0] = zero16();
      wave_mma<2, 1>(acc, xT, SL, BT + (32 * w) * SL, SL, 128);
      u16* st = (u16*)(p->ws + (dir ? A_STB : A_STF)) + ((size_t)((b * NCH + c) * 8 + head)) * 64 * 128;
#pragma unroll
      for (int i = 0; i < 2; ++i)
#pragma unroll
        for (int t = 0; t < 16; ++t) st[(i * 32 + crow(t, h)) * 128 + 32 * w + r] = f2bf(acc[i][0][t]);
    }
  }
}

DI void phase_ssd2(PP p) {
  const float* cdec = (const float*)(p->ws + S_CDEC);
  const int total = NB * 8 * 64 * 128;
  for (int i = get_bid() * 256 + get_tid(); i < total; i += gridDim.x * 256) {
    int dir = i / (NB * 8 * 4096), rem = i % (NB * 8 * 4096), b = rem / (8 * 4096), rem2 = rem % (8 * 4096), head = rem2 / 4096, pn2 = rem2 % 4096;
    unsigned* S = (unsigned*)(p->ws + (dir ? A_STB : A_STF));
    float s0 = 0.f, s1 = 0.f;
#pragma unroll 1
    for (int k0 = 0; k0 < NCH; k0 += 6) {
      unsigned stv[6]; float dc[6]; unsigned idx[6];
#pragma unroll
      for (int u = 0; u < 6; ++u) {
        int k = k0 + u; int c = dir == 0 ? k : (k < 2 ? 1 - k : NCH + 1 - k);
        idx[u] = (unsigned)(((b * NCH + c) * 8 + head) * 4096 + pn2);
        stv[u] = S[idx[u]]; dc[u] = cdec[((dir * NB + b) * NCH + c) * 8 + head];
      }
#pragma unroll
      for (int u = 0; u < 6; ++u) { S[idx[u]] = pack2(s0, s1); s0 = s0 * dc[u] + lo2f(stv[u]); s1 = s1 * dc[u] + hi2f(stv[u]); }
    }
  }
}

DI void phase_ssd3(PP p, int l, bool need_ctx, unsigned char* ldsb) {
  const int tid = get_tid(), lane = tid & 63, w = tid >> 6, r = lane & 31, h = lane >> 5;
  const u16* xsact = (const u16*)(p->ws + A_XSACT); const u16* bcact = (const u16*)(p->ws + A_BCACT); const float* dtraw = (const float*)(p->ws + S_DT);
  const float* cw = p->in[I_SCW] + (size_t)l * 5 * 1024; const float* cb = p->in[I_SCB] + l * 1024;
  u16* Cs = (u16*)ldsb; u16* Bs = Cs + 128 * SL; float* cum = (float*)(Bs + 128 * SL);
  u16* ybuf = (u16*)(p->ws + A_YBUF);
  for (int item = get_bid(); item < NB * NCH * 8; item += gridDim.x) {
    const int b = item / (NCH * 8), rem = item % (NCH * 8), c = rem >> 3, head = rem & 7, g = head >> 2;
    if (c < 2 && !need_ctx) continue;
    const int rows0 = b * TT + c * 128;
    const int lo = c < 2 ? b * TT : b * TT + CTX, hi = c < 2 ? b * TT + CTX : (b + 1) * TT;
    __syncthreads();
    if (w < 2) {
      const int dir = w;
      const float bias = p->in[I_SDTB][l * 16 + dir * 8 + head]; const float Ah = -__expf(p->in[I_SALOG][l * 16 + dir * 8 + head]);
      float d0 = softplusf(dtraw[(size_t)(rows0 + 2 * lane) * 16 + dir * 8 + head] + bias);
      float d1 = softplusf(dtraw[(size_t)(rows0 + 2 * lane + 1) * 16 + dir * 8 + head] + bias);
      float a0 = d0 * Ah, a1 = d1 * Ah;
      float P1 = wave_incl_scan(a0 + a1), P0 = P1 - a1;
      if (dir == 0) { cum[2 * lane] = P0; cum[2 * lane + 1] = P1; cum[128 + 2 * lane] = d0; cum[128 + 2 * lane + 1] = d1; }
      else { cum[256 + 2 * lane] = P0 - a0; cum[256 + 2 * lane + 1] = P1 - a1; cum[384 + 2 * lane] = d0; cum[384 + 2 * lane + 1] = d1; if (lane == 63) cum[512] = P1; }
    }
#pragma unroll 2
    for (int i = 0; i < 8; ++i) {
      int id = tid + 256 * i, lrow = id >> 4, ch = (id & 15) * 8; float v[8];
      ssd_act8(bcact, rows0 + lrow, 256 + g * 128 + ch, v);
      *(U4*)(Cs + lrow * SL + ch) = pack8(v);
      ssd_act8(bcact, rows0 + lrow, g * 128 + ch, v);
      *(U4*)(Bs + lrow * SL + ch) = pack8(v);
    }
    __syncthreads();
    f32x16 G[1][4]; for (int j = 0; j < 4; ++j) G[0][j] = zero16();
    wave_mma<1, 4>(G, Cs + (32 * w) * SL, SL, Bs, SL, 128);
    __syncthreads();
    {
      const u16* sf = (const u16*)(p->ws + A_STF) + ((size_t)((b * NCH + c) * 8 + head)) * 8192;
      const u16* sb = (const u16*)(p->ws + A_STB) + ((size_t)((b * NCH + c) * 8 + head)) * 8192;
#pragma unroll 2
      for (int i = 0; i < 4; ++i) {
        int id = tid + 256 * i, pp = id >> 4, n8 = (id & 15) * 8;
        *(U4*)(Bs + pp * SL + n8) = *(const U4*)(sf + pp * 128 + n8);
        *(U4*)(Bs + (64 + pp) * SL + n8) = *(const U4*)(sb + pp * 128 + n8);
      }
    }
    __syncthreads();
    f32x16 af[1][2], ab[1][2]; af[0][0] = zero16(); af[0][1] = zero16(); ab[0][0] = zero16(); ab[0][1] = zero16();
    wave_mma<1, 2>(af, Cs + (32 * w) * SL, SL, Bs, SL, 128);
    wave_mma<1, 2>(ab, Cs + (32 * w) * SL, SL, Bs + 64 * SL, SL, 128);
    f32x16 ad[1][2];
    { const float PbTot = cum[512];
#pragma unroll
      for (int j = 0; j < 2; ++j)
#pragma unroll
        for (int t = 0; t < 16; ++t) { const int lr = 32 * w + crow(t, h); ad[0][j][t] = __expf(cum[lr]) * af[0][j][t] + __expf(PbTot - cum[256 + lr]) * ab[0][j][t]; } }
    __syncthreads();
    {
#pragma unroll
      for (int j = 0; j < 4; ++j) {
        const int s = 32 * j + r; const float Pfs = cum[s], dtfs = cum[128 + s], Ebs = cum[256 + s], dtbs = cum[384 + s];
#pragma unroll
        for (int t = 0; t < 16; ++t) {
          const int lr = 32 * w + crow(t, h);
          float mf = (s <= lr) ? __expf(fminf(cum[lr] - Pfs, 0.f)) * dtfs : 0.f;
          float mb = (s >= lr) ? __expf(fminf(Ebs - cum[256 + lr], 0.f)) * dtbs : 0.f;
          Bs[lr * SL + s] = f2bf(G[0][j][t] * (mf + mb));
        }
      }
#pragma unroll 2
      for (int i = 0; i < 4; ++i) { int id = tid + 256 * i, lrow = id >> 3, ch = (id & 7) * 8; float v[8];
        ssd_act8(xsact, rows0 + lrow, head * 64 + ch, v);
#pragma unroll
        for (int e = 0; e < 8; ++e) Cs[(ch + e) * SL + lrow] = f2bf(v[e]); }
    }
    __syncthreads();
    wave_mma<1, 2>(ad, Bs + (32 * w) * SL, SL, Cs, SL, 128);
    const float Dh = p->in[I_SD][l * 8 + head];
#pragma unroll
    for (int j = 0; j < 2; ++j)
#pragma unroll
      for (int t = 0; t < 16; ++t) {
        const int lr = 32 * w + crow(t, h), pp = 32 * j + r;
        float y = ad[0][j][t] + Dh * bf2f(Cs[pp * SL + lr]);
        ybuf[(size_t)(rows0 + lr) * 512 + head * 64 + pp] = f2bf(y);
      }
  }
}

DI void phase_ssd4(PP p, int l, bool need_ctx) {
  const int lane = get_tid() & 63, w = get_tid() >> 6;
  u16* zx = (u16*)(p->ws + A_SSDZX); const u16* ybuf = (const u16*)(p->ws + A_YBUF); const float* gn = p->in[I_SNORM] + l * 512;
  for (int r = get_bid() * 4 + w; r < ROWS; r += gridDim.x * 4) {
    int t = r % TT; if (t < CTX && !need_ctx) continue;
    U4 yv = *(const U4*)(ybuf + (size_t)r * 512 + lane * 8), zv = *(const U4*)(zx + (size_t)r * 1536 + lane * 8);
    float y[8], z[8]; unpack8(yv, y); unpack8(zv, z);
    float ss = 0.f;
#pragma unroll
    for (int e = 0; e < 8; ++e) { y[e] *= siluf(z[e]); ss += y[e] * y[e]; }
    ss = wave_sum(ss); float rstd = rsqrtf(ss * (1.f / 512.f) + EPS);
#pragma unroll
    for (int e = 0; e < 8; ++e) y[e] *= rstd * gn[lane * 8 + e];
    *(U4*)(zx + (size_t)r * 1536 + lane * 8) = pack8(y);
  }
}

DI F2 cmul(F2 a, F2 b) { return mkf2(a.x * b.x - a.y * b.y, a.x * b.y + a.y * b.x); }
DI F2 cmulc(F2 a, F2 b) { return mkf2(a.x * b.x + a.y * b.y, a.y * b.x - a.x * b.y); }
#define LP(i) ((i) + ((i) >> 5))
DI F2 twid2(int j) { const float r = (float)j * (1.f / 16384.f); return mkf2(__builtin_amdgcn_cosf(r), -__builtin_amdgcn_sinf(r)); }
DI F2 twid(int k) { const float r = (float)k * (1.f / 8192.f); return mkf2(__builtin_amdgcn_cosf(r), -__builtin_amdgcn_sinf(r)); }
DI void fft_fwd(F2* L) {
  const int tid = get_tid();
#pragma unroll 1
  for (int s = 0; s < 12; s += 2) {
    const int hB = 2048 >> s, lg = 11 - s;
#pragma unroll 8
    for (int g = tid; g < 2048; g += 256) {
      const int pos = g & (hB - 1), grp = g >> lg;
      const int i0 = (grp << (lg + 2)) + pos;
      F2 x0 = L[LP(i0)], x1 = L[LP(i0 + hB)], x2 = L[LP(i0 + 2 * hB)], x3 = L[LP(i0 + 3 * hB)];
      const F2 wA = twid(pos << s); const F2 wA2 = mkf2(wA.y, -wA.x); const F2 wB = cmul(wA, wA);
      F2 a0 = mkf2(x0.x + x2.x, x0.y + x2.y), a2 = cmul(mkf2(x0.x - x2.x, x0.y - x2.y), wA);
      F2 a1 = mkf2(x1.x + x3.x, x1.y + x3.y), a3 = cmul(mkf2(x1.x - x3.x, x1.y - x3.y), wA2);
      L[LP(i0)] = mkf2(a0.x + a1.x, a0.y + a1.y); L[LP(i0 + hB)] = cmul(mkf2(a0.x - a1.x, a0.y - a1.y), wB);
      L[LP(i0 + 2 * hB)] = mkf2(a2.x + a3.x, a2.y + a3.y); L[LP(i0 + 3 * hB)] = cmul(mkf2(a2.x - a3.x, a2.y - a3.y), wB);
    }
    __syncthreads();
  }
#pragma unroll 8
  for (int q = tid; q < 4096; q += 256) { F2 u = L[LP(2 * q)], v = L[LP(2 * q + 1)]; L[LP(2 * q)] = mkf2(u.x + v.x, u.y + v.y); L[LP(2 * q + 1)] = mkf2(u.x - v.x, u.y - v.y); }
  __syncthreads();
}
DI void fft_inv(F2* L) {
  const int tid = get_tid();
#pragma unroll 8
  for (int q = tid; q < 4096; q += 256) { F2 u = L[LP(2 * q)], v = L[LP(2 * q + 1)]; L[LP(2 * q)] = mkf2(u.x + v.x, u.y + v.y); L[LP(2 * q + 1)] = mkf2(u.x - v.x, u.y - v.y); }
  __syncthreads();
#pragma unroll 1
  for (int s = 10; s >= 0; s -= 2) {
    const int hB = 2048 >> s, lg = 11 - s;
#pragma unroll 8
    for (int g = tid; g < 2048; g += 256) {
      const int pos = g & (hB - 1), grp = g >> lg;
      const int i0 = (grp << (lg + 2)) + pos;
      F2 y0 = L[LP(i0)], y1 = L[LP(i0 + hB)], y2 = L[LP(i0 + 2 * hB)], y3 = L[LP(i0 + 3 * hB)];
      const F2 wA = twid(pos << s); const F2 wA2 = mkf2(wA.y, -wA.x); const F2 wB = cmul(wA, wA);
      F2 v1 = cmulc(y1, wB), v3 = cmulc(y3, wB);
      F2 a0 = mkf2(y0.x + v1.x, y0.y + v1.y), a1 = mkf2(y0.x - v1.x, y0.y - v1.y);
      F2 a2 = mkf2(y2.x + v3.x, y2.y + v3.y), a3 = mkf2(y2.x - v3.x, y2.y - v3.y);
      F2 u2 = cmulc(a2, wA), u3 = cmulc(a3, wA2);
      L[LP(i0)] = mkf2(a0.x + u2.x, a0.y + u2.y); L[LP(i0 + 2 * hB)] = mkf2(a0.x - u2.x, a0.y - u2.y);
      L[LP(i0 + hB)] = mkf2(a1.x + u3.x, a1.y + u3.y); L[LP(i0 + 3 * hB)] = mkf2(a1.x - u3.x, a1.y - u3.y);
    }
    __syncthreads();
  }
}
DI float hy_delta(int c) {
  const float a = -4.605170185988091f / 1.5f, bq = -4.605170185988091f / 0.3f;
  return fabsf(a + (bq - a) * ((float)c / 511.f));
}
DI float block_sum(float v, float* red  ) {
  v = wave_sum(v);
  __syncthreads();
  if ((get_tid() & 63) == 0) red[get_tid() >> 6] = v;
  __syncthreads();
  return red[0] + red[1] + red[2] + red[3];
}

DI void phase_hyspec(PP p, int l, TileIter& it, unsigned char* ldsb) {
  const int tid = get_tid();
  F2* L = (F2*)ldsb; float* misc = (float*)(ldsb + 67584);
  float* tmpF = (float*)ldsb; float* tmpB = tmpF + FN;
  const F2* W2 = (const F2*)(p->ws + S_W2); const u16* hid = (const u16*)(p->ws + S_HID);
  const float* w3 = p->in[I_HW3] + (size_t)l * 64 * 2048;
  F2* Gs = (F2*)(p->ws + A_GSPEC);
  FOR_TILES(it, 1024, item) {
    const int o = item >> 9, c = item & 511;
    __syncthreads();
    if (tid < 64) misc[tid] = w3[tid * 2048 + o * 512 + c]; else if (tid < 128) misc[tid] = w3[(tid - 64) * 2048 + 1024 + o * 512 + c];
    __syncthreads();
    const float delta = hy_delta(c);
    float ss = 0.f;
#pragma unroll 1
    for (int i = 0; i < 32; ++i) {
      const int t = tid + 256 * i; const u16* hr = hid + (size_t)t * 64;
      float df = 0.f, db = 0.f;
#pragma unroll
      for (int k8 = 0; k8 < 8; ++k8) { U4 hq = *(const U4*)(hr + k8 * 8); float hv[8]; unpack8(hq, hv);
#pragma unroll
        for (int e = 0; e < 8; ++e) { df += hv[e] * misc[k8 * 8 + e]; db += hv[e] * misc[64 + k8 * 8 + e]; } }
      const float dec = __expf(-((float)t / 8191.f) * delta);
      df *= dec; db *= dec; tmpF[t] = df; tmpB[t] = db;
      ss += (t == 0) ? (df + db) * (df + db) : (df * df + db * db);
    }
    ss = block_sum(ss, misc + 128);
    const float scale = rsqrtf(ss + EPS) * (1.f / 16384.f);
    F2* zs = (F2*)(p->ws + A_ZSAVE) + (size_t)get_bid() * FN;
#pragma unroll 8
    for (int i = 0; i < 32; ++i) { int j = tid + 256 * i; zs[j] = mkf2(tmpF[j] * scale, tmpB[j == 0 ? 0 : FN - j] * scale); }
    __syncthreads();
#pragma unroll 8
    for (int i = 0; i < 32; ++i) { int j = tid + 256 * i; F2 v = zs[j]; L[LP(j)] = mkf2(v.x + v.y, 0.f); }
    __syncthreads();
    fft_fwd(L);
    F2* dst = Gs + (size_t)item * 2 * FN;
#pragma unroll 8
    for (int i = 0; i < 32; ++i) dst[tid + 256 * i] = L[LP(tid + 256 * i)];
    __syncthreads();
#pragma unroll 8
    for (int i = 0; i < 32; ++i) { int j = tid + 256 * i; F2 v = zs[j]; float gv = (j == 0 ? v.x + v.y : v.x - v.y); F2 wv = twid2(j); L[LP(j)] = mkf2(gv * wv.x, gv * wv.y); }
    __syncthreads();
    fft_fwd(L);
#pragma unroll 8
    for (int i = 0; i < 32; ++i) dst[FN + tid + 256 * i] = L[LP(tid + 256 * i)];
  }
  it.off += 1024;
}

DI float hy_u_lat_sh(const u16* PT, int b, int col, int j, float w0, float w1, float w2, float bias) {
  const u16* rowp = PT + ((size_t)b * 1536 + col) * TT + CTX;
  const int lane = get_tid() & 63;
  const float c = bf2f(rowp[j]);
  float lft = __shfl_up(c, 1), rgt = __shfl_down(c, 1);
  if (lane == 0) lft = (j > 0) ? bf2f(rowp[j - 1]) : 0.f;
  if (lane == 63) rgt = (j < SEQ - 1) ? bf2f(rowp[j + 1]) : 0.f;
  return bias + w1 * c + w0 * lft + w2 * rgt;
}
DI float hy_u_lat(const u16* PT, int b, int col, int j, float w0, float w1, float w2, float bias) {
  const u16* rowp = PT + ((size_t)b * 1536 + col) * TT + CTX;
  float v = bias + w1 * bf2f(rowp[j]);
  if (j > 0) v += w0 * bf2f(rowp[j - 1]);
  if (j < SEQ - 1) v += w2 * bf2f(rowp[j + 1]);
  return v;
}
DI float hy_u_ctx(const u16* PT, int b, int col, int j, float w0, float w1, float w2, float bias) {
  const u16* rowp = PT + ((size_t)b * 1536 + col) * TT;
  float v = bias + w1 * bf2f(rowp[j]);
  if (j > 0) v += w0 * bf2f(rowp[j - 1]);
  if (j < CTX - 1) v += w2 * bf2f(rowp[j + 1]);
  return v;
}

DI void phase_hyconv(PP p, int l, bool need_ctx, unsigned char* ldsb) {
  const int tid = get_tid();
  F2* L = (F2*)ldsb; float* misc = (float*)(ldsb + 67584);
  const F2* W2 = (const F2*)(p->ws + S_W2);
  const u16* PT = (const u16*)(p->ws + A_PTHY); const F2* Gs = (const F2*)(p->ws + A_GSPEC);
  u16* ohy = (u16*)(p->ws + A_OHY);
  const float* cw = p->in[I_HCW] + (size_t)l * 3 * 1536; const float* cb = p->in[I_HCB] + l * 1536; const float* hb = p->in[I_HBIAS] + l * 1024;
  const int nlat = 1024, nctx = need_ctx ? 512 : 0;
  for (int item = get_bid(); item < nlat + nctx; item += gridDim.x) {
    __syncthreads();
    if (item < nlat) {
      const int bp = item >> 9, c = item & 511, b0 = 2 * bp, b1 = b0 + 1;
      unsigned* zs = (unsigned*)(p->ws + A_ZSAVE) + (size_t)get_bid() * FN;
      unsigned* ys = (unsigned*)(p->ws + A_YSAVE) + (size_t)get_bid() * FN;
      { const float w0 = cw[c], w1 = cw[1536 + c], w2 = cw[3072 + c], bi = cb[c];
#pragma unroll 4
        for (int i = 0; i < 32; ++i) { int j = tid + 256 * i; F2 z = mkf2(hy_u_lat(PT, b0, c, j, w0, w1, w2, bi), hy_u_lat(PT, b1, c, j, w0, w1, w2, bi)); const unsigned zp = pack2(z.x, z.y); zs[j] = zp; L[LP(j)] = mkf2(lo2f(zp), hi2f(zp)); } }
      __syncthreads();
#pragma unroll 1
      for (int o = 0; o < 2; ++o) {
        const F2* Ge = Gs + ((size_t)(o * 512 + c) * 2) * FN; const F2* Go = Ge + FN;
        fft_fwd(L);
#pragma unroll 16
        for (int i = 0; i < 32; ++i) { int k = tid + 256 * i; L[LP(k)] = cmul(L[LP(k)], Ge[k]); }
        __syncthreads();
        fft_inv(L);
#pragma unroll 8
        for (int i = 0; i < 32; ++i) { int j = tid + 256 * i; F2 yv = L[LP(j)]; ys[j] = pack2(yv.x, yv.y); }
        __syncthreads();
#pragma unroll 8
        for (int i = 0; i < 32; ++i) { int j = tid + 256 * i; unsigned zp = zs[j]; L[LP(j)] = cmul(mkf2(lo2f(zp), hi2f(zp)), twid2(j)); }
        __syncthreads();
        fft_fwd(L);
#pragma unroll 16
        for (int i = 0; i < 32; ++i) { int k = tid + 256 * i; L[LP(k)] = cmul(L[LP(k)], Go[k]); }
        __syncthreads();
        fft_inv(L);
        const int col = (1 + o) * 512 + c;
        const float w0 = cw[col], w1 = cw[1536 + col], w2 = cw[3072 + col], bi = cb[col], hbias = hb[o * 512 + c];
#pragma unroll 4
        for (int i = 0; i < 32; ++i) { int j = tid + 256 * i; F2 yo = cmulc(L[LP(j)], twid2(j)); unsigned yp = ys[j], zp = zs[j]; F2 ye = mkf2(lo2f(yp), hi2f(yp)); F2 z = mkf2(lo2f(zp), hi2f(zp));
          float yr = ye.x + yo.x, yi = ye.y + yo.y;
          float zr = hy_u_lat(PT, b0, col, j, w0, w1, w2, bi) * (yr + hbias * z.x);
          float zi = hy_u_lat(PT, b1, col, j, w0, w1, w2, bi) * (yi + hbias * z.y);
          if (o == 0) { const unsigned zq = pack2(zr, zi); zs[j] = zq; L[LP(j)] = mkf2(lo2f(zq), hi2f(zq)); }
          else { ohy[((size_t)b0 * TT + CTX + j) * 512 + c] = f2bf(zr); ohy[((size_t)b1 * TT + CTX + j) * 512 + c] = f2bf(zi); } }
        __syncthreads();
      }
    } else {
      const int c = item - nlat, t = tid;
      float* g = (float*)ldsb;
      float* zs = g + 1024;
      float* wv = zs + 256;
      float* red = wv + 256;
      const float* hidc = (const float*)(p->ws + S_HIDC); const float* w3 = p->in[I_HW3] + (size_t)l * 64 * 2048;
      { int which = tid >> 6, k = tid & 63; int dir = which >> 1, o = which & 1; wv[tid] = w3[k * 2048 + dir * 1024 + o * 512 + c]; }
      __syncthreads();
      const float dec = __expf(-((float)t / 255.f) * hy_delta(c));
      float f[2], bk[2];
      { float d[4] = {0.f, 0.f, 0.f, 0.f};
#pragma unroll 4
        for (int k = 0; k < 64; ++k) { float hv = hidc[t * 64 + k]; d[0] += hv * wv[k]; d[1] += hv * wv[64 + k]; d[2] += hv * wv[128 + k]; d[3] += hv * wv[192 + k]; }
        f[0] = d[0] * dec; f[1] = d[1] * dec; bk[0] = d[2] * dec; bk[1] = d[3] * dec; }
      for (int o = 0; o < 2; ++o) {
        float ss = (t == 0) ? (f[o] + bk[o]) * (f[o] + bk[o]) : (f[o] * f[o] + bk[o] * bk[o]);
        ss = block_sum(ss, red);
        float sc = rsqrtf(ss + EPS);
        if (t == 0) { g[o * 512] = (f[o] + bk[o]) * sc; g[o * 512 + 256] = 0.f; }
        else { g[o * 512 + t] = f[o] * sc; g[o * 512 + 512 - t] = bk[o] * sc; }
      }
      __syncthreads();
#pragma unroll 1
      for (int b = 0; b < NB; ++b) {
        float z = hy_u_ctx(PT, b, c, t, cw[c], cw[1536 + c], cw[3072 + c], cb[c]);
        for (int o = 0; o < 2; ++o) {
          __syncthreads();
          zs[t] = z;
          __syncthreads();
          float y = 0.f;
#pragma unroll 4
          for (int s = 0; s < 256; ++s) y += zs[s] * g[o * 512 + ((t - s) & 511)];
          const int col = (1 + o) * 512 + c;
          z = hy_u_ctx(PT, b, col, t, cw[col], cw[1536 + col], cw[3072 + col], cb[col]) * (y + hb[o * 512 + c] * z);
        }
        ohy[((size_t)b * TT + t) * 512 + c] = f2bf(z);
      }
    }
  }
}

DI void phase_merge(PP p, u16* lds, bool skipc) {
  unsigned char* ws = p->ws;
  const u16* H = (const u16*)(ws + H_OFF); const u16* Wg = (const u16*)(ws + W_WIN) + (size_t)OFF_GATE * DM; const u16* Wbr = (const u16*)(ws + W_BR);
  u16* mixed = (u16*)(ws + A_MIXED);
  const int ntile = (skipc ? NB * 64 : ROWS / 128) * 8;
  for (int ti = get_bid(); ti < ntile; ti += gridDim.x) {
    int tm = ti >> 3, tn = ti & 7;
    if (skipc) tm = NCH * (tm >> 6) + 2 + (tm & 63);
    unsigned amp[2][2][8];
#pragma unroll
    for (int a = 0; a < 2; ++a)
#pragma unroll
      for (int bq = 0; bq < 2; ++bq)
#pragma unroll
        for (int t = 0; t < 8; ++t) amp[a][bq][t] = 0u;
#pragma unroll 1
    for (int i = 0; i < 4; ++i) {
      unsigned gp[2][2][8];
      {
        f32x16 ag[2][2]; zero_acc<2>(ag);
        gemm_acc<2>(ag, H + (size_t)tm * 128 * DM, DM, Wg + ((size_t)i * 1024 + tn * 128) * DM, DM, DM, lds);
#pragma unroll
        for (int a = 0; a < 2; ++a)
#pragma unroll
          for (int bq = 0; bq < 2; ++bq)
#pragma unroll
            for (int t = 0; t < 8; ++t) gp[a][bq][t] = pack2(sigmoidf(ag[a][bq][2 * t]), sigmoidf(ag[a][bq][2 * t + 1]));
      }
      f32x16 ao[2][2]; zero_acc<2>(ao);
      const u16* Oi = (const u16*)(ws + (i == 0 ? A_DAQ : i == 1 ? A_SSDZX : i == 2 ? A_OMLA : A_OHY)); const int ldi = (i == 1) ? 1536 : 512;
      gemm_acc<2>(ao, Oi + (size_t)tm * 128 * ldi, ldi, Wbr + ((size_t)i * 1024 + tn * 128) * 512, 512, 512, lds);
#pragma unroll
      for (int a = 0; a < 2; ++a)
#pragma unroll
        for (int bq = 0; bq < 2; ++bq)
#pragma unroll
          for (int t = 0; t < 8; ++t) amp[a][bq][t] = pack2(lo2f(amp[a][bq][t]) + lo2f(gp[a][bq][t]) * ao[a][bq][2 * t], hi2f(amp[a][bq][t]) + hi2f(gp[a][bq][t]) * ao[a][bq][2 * t + 1]);
    }
    f32x16 am[2][2];
#pragma unroll
    for (int a = 0; a < 2; ++a)
#pragma unroll
      for (int bq = 0; bq < 2; ++bq)
#pragma unroll
        for (int t = 0; t < 8; ++t) { am[a][bq][2 * t] = lo2f(amp[a][bq][t]); am[a][bq][2 * t + 1] = hi2f(amp[a][bq][t]); }
    store_tile_bf16<2>(am, mixed, DM, tm * 128, tn * 128, DM);
  }
}

DI void phase_ffn1(PP p, u16* lds, bool skipc) {
  unsigned char* ws = p->ws;
  const u16* H = (const u16*)(ws + H_OFF); const u16* W1 = (const u16*)(ws + W_F1); const u16* W3 = (const u16*)(ws + W_F3);
  u16* act = (u16*)(ws + A_ACT);
  const int ntn = FFN / 128, ntile = (skipc ? NB * 64 : ROWS / 128) * ntn;
  for (int ti = get_bid(); ti < ntile; ti += gridDim.x) {
    int tm = ti / ntn, tn = ti % ntn;
    if (skipc) tm = NCH * (tm >> 6) + 2 + (tm & 63);
    f32x16 a1[2][2], a3[2][2]; zero_acc<2>(a1); zero_acc<2>(a3);
    gemm_acc<2>(a1, H + (size_t)tm * 128 * DM, DM, W1 + (size_t)tn * 128 * DM, DM, DM, lds);
    gemm_acc<2>(a3, H + (size_t)tm * 128 * DM, DM, W3 + (size_t)tn * 128 * DM, DM, DM, lds);
#pragma unroll
    for (int a = 0; a < 2; ++a)
#pragma unroll
      for (int bq = 0; bq < 2; ++bq)
#pragma unroll
        for (int t = 0; t < 16; ++t) a1[a][bq][t] = siluf(a1[a][bq][t]) * a3[a][bq][t];
    store_tile_bf16<2>(a1, act, FFN, tm * 128, tn * 128, FFN);
  }
}

DI void phase_gemm_mla(PP p, u16* lds) {
  unsigned char* ws = p->ws;
  const u16* mc = (const u16*)(ws + A_MLAC);
  TileIter it{0};
  gemm_job(it, mc, 704, (const u16*)(ws + W_UQ), 384, 384, 768, 0, ws + A_MLAQ, 768, lds);
  const u16* Wkv = (const u16*)(ws + W_UKV);
  const int ntile = (ROWS / 128) * 8;
  FOR_TILES(it, ntile, ti) {
    int tm = ti >> 3, tn = ti & 7, hd = tn >> 1;
    f32x16 acc[2][2]; zero_acc<2>(acc);
    if ((tn & 1) == 0) {
      gemm_acc<2, true>(acc, mc + (size_t)tm * 128 * 704 + 384, 704, Wkv + (size_t)tn * 128 * 256, 256, 256, lds);
      store_tile_bf16<2>(acc, (u16*)(ws + A_MLAKN), 512, tm * 128, hd * 128, 512);
    } else {
      gemm_acc<2, false>(acc, mc + (size_t)tm * 128 * 704 + 384, 704, Wkv + (size_t)tn * 128 * 256, 256, 256, lds);
      store_tile_T(acc, (u16*)(ws + A_MLAVT), 512, tm * 128, hd * 128);
    }
  }
}


#define XB_TMO      128
#define XB_XCNT(j)  (256  + 64 * (j))
#define XB_XSUB(j)  (1280 + 64 * (j))
#define XB_XGEN(j)  (2304 + 64 * (j))
#define XB_TOP      3328
#define XB_TOPGEN   3392
#define XCD_BAR_WORDS 3456
#define XB_SPIN_CAP (1u << 20)
#define LAS __attribute__((address_space(3)))
DI unsigned xb_ld(unsigned* p)              { return __hip_atomic_load(p, __ATOMIC_RELAXED, __HIP_MEMORY_SCOPE_AGENT); }
DI unsigned xb_add(unsigned* p, unsigned v) { return __hip_atomic_fetch_add(p, v, __ATOMIC_RELAXED, __HIP_MEMORY_SCOPE_AGENT); }
DI unsigned xb_xcc_id() { return (unsigned)__builtin_amdgcn_s_getreg((3 << 11) | 20) & 0xFu; }
#define XB_SPIN(cond, bar) do { unsigned _sp = 0; while (cond) { __builtin_amdgcn_s_sleep(1); \
    if ((++_sp & 255u) == 0u) { if (xb_ld(&(bar)[XB_TMO])) break; if (_sp > XB_SPIN_CAP) { atomicAdd(&(bar)[XB_TMO], 1u); break; } } } } while (0)
struct XcdBarrier { unsigned* bar; unsigned x; volatile LAS unsigned* st; };
DI XcdBarrier xcd_barrier_post(unsigned* bar, volatile LAS unsigned* st) {
  XcdBarrier b; b.bar = bar; b.x = xb_xcc_id(); b.st = st;
  if (threadIdx.x == 0) (void)xb_add(&bar[XB_XCNT(b.x)], 1u);
  return b;
}
DI void xcd_barrier_complete(unsigned* bar, unsigned x, unsigned& nloc, unsigned& nx) {
  const unsigned G = gridDim.x * gridDim.y * gridDim.z;
  unsigned sum, cnt, mine, sp = 0u;
  for (;;) {
    sum = 0u; cnt = 0u; mine = 0u;
#pragma unroll
    for (unsigned j = 0; j < 16; ++j) { const unsigned c = xb_ld(&bar[XB_XCNT(j)]); sum += c; cnt += (c > 0u) ? 1u : 0u; mine = (j == x) ? c : mine; }
    if (sum == G) break;
    __builtin_amdgcn_s_sleep(1);
    if ((++sp & 255u) == 0u) { if (xb_ld(&bar[XB_TMO])) break; if (sp > XB_SPIN_CAP) { atomicAdd(&bar[XB_TMO], 1u); break; } }
  }
  nloc = mine > 0u ? mine : 1u; nx = cnt > 0u ? cnt : 1u;
}
DI void xcd_barrier(const XcdBarrier& b) {
  asm volatile("s_waitcnt vmcnt(0)" ::: "memory");
  __syncthreads();
  if (threadIdx.x == 0) {
    unsigned* bar = b.bar;
    __builtin_amdgcn_s_waitcnt(0);
    unsigned nloc = b.st[0], nx = b.st[1];
    if (nloc == 0u) { xcd_barrier_complete(bar, b.x, nloc, nx); b.st[0] = nloc; b.st[1] = nx; }
    const unsigned old = xb_add(&bar[XB_XSUB(b.x)], 1u);
    const unsigned gen = old / nloc;
    if (old + 1u == (gen + 1u) * nloc) {
      __builtin_amdgcn_fence(__ATOMIC_RELEASE, "agent");
      asm volatile("s_waitcnt vmcnt(0)" ::: "memory");
      const unsigned og = xb_add(&bar[XB_TOP], 1u);
      const unsigned tg = og / nx;
      if (og + 1u == (tg + 1u) * nx) xb_add(&bar[XB_TOPGEN], 1u);
      else XB_SPIN(xb_ld(&bar[XB_TOPGEN]) == tg, bar);
      __builtin_amdgcn_fence(__ATOMIC_ACQUIRE, "agent");
      xb_add(&bar[XB_XGEN(b.x)], 1u);
      asm volatile("s_waitcnt vmcnt(0)" ::: "memory");
    } else {
      XB_SPIN(xb_ld(&bar[XB_XGEN(b.x)]) == gen, bar);
      __builtin_amdgcn_fence(__ATOMIC_ACQUIRE, "agent");
      asm volatile("s_waitcnt vmcnt(0)" ::: "memory");
    }
  }
  __syncthreads();
}

constexpr int NPH = 21;
__host__ __device__ inline bool phase_empty(int ph) { int l = ph / NPH, k = ph % NPH; return l == 1 && (k == 1 || k == 2); }

DI void run_phase(PP p, int ph, unsigned char* lds) {
  const int l = ph / NPH, k = ph % NPH;
  const bool last = (l == 1), need_ctx = !last;
  unsigned char* ws = p->ws;
  const u16* H = (const u16*)(ws + H_OFF);
  const u16* Win = (const u16*)(ws + W_WIN);
#ifdef ONLY_PHASE
  if (k != ONLY_PHASE) return;
#endif
  switch (k) {
    case 0: phase_conv(p, l, lds); break;
    case 1: phase_modfin(p); break;
    case 2: phase_rowwise(p, true, nullptr, nullptr, 0, 0, true, p->in[I_NMPRE], 0, 0, 1, false); break;
    case 3: { TileIter it{0};
      gemm_job(it, H, DM, Win + (size_t)OFF_HY * DM, DM, DM, 1536, 2, ws + A_PTHY, 0, (u16*)lds, last);
      phase_hyspec(p, l, it, lds); } break;
    case 4: phase_hyconv(p, l, need_ctx, lds); break;
    case 5: { TileIter it{0};
      gemm_job(it, H, DM, Win + (size_t)(OFF_DA + 0) * DM, DM, DM, 512, 0, ws + A_DAQ, 512, (u16*)lds);
      gemm_job(it, H, DM, Win + (size_t)(OFF_DA + 512) * DM, DM, DM, 512, 0, ws + A_DAK, 512, (u16*)lds);
      gemm_job(it, H, DM, Win + (size_t)(OFF_DA + 1024) * DM, DM, DM, 512, 2, ws + A_DAVT, 0, (u16*)lds);
      gemm_job(it, H, DM, Win + (size_t)OFF_MLA * DM, DM, DM, 704, 0, ws + A_MLAC, 704, (u16*)lds); } break;
    case 6: phase_rope(p, l); break;
    case 7: phase_gemm_mla(p, (u16*)lds); break;
    case 8: phase_attn(p, l, need_ctx, lds);
#ifdef PROBE_MLA
      phase_attn(p, l, need_ctx, lds, 1);
#endif
      break;
    case 9: { TileIter it{0};
      gemm_job(it, H, DM, Win + (size_t)OFF_SSD * DM, DM, DM, 1536, 0, ws + A_SSDZX, 1536, (u16*)lds);
      gemm_job(it, H, DM, Win + (size_t)(OFF_SSD + 1536) * DM, DM, DM, 16, 1, ws + S_DT, 16, (u16*)lds); } break;
    case 10: phase_ssdconv(p, l); break;
    case 11: phase_ssd1(p, l, lds); break;
    case 12: phase_ssd2(p); break;
    case 13: phase_ssd3(p, l, need_ctx, lds); break;
    case 14: phase_ssd4(p, l, need_ctx); break;
    case 15: phase_merge(p, (u16*)lds, last); break;
    case 16: { TileIter it{0}; gemm_job(it, (const u16*)(ws + A_MIXED), DM, (const u16*)(ws + W_OUT), DM, DM, DM, 0, ws + A_YOUT, DM, (u16*)lds, last); } break;
    case 17: phase_rowwise(p, l == 0, (const u16*)(ws + A_YOUT), p->in[I_NMPOST] + l * DM, l, 2, true, p->in[I_NFPRE] + l * DM, l, 3, 4, last); break;
    case 18: phase_ffn1(p, (u16*)lds, last); break;
    case 19: { TileIter it{0}; gemm_job(it, (const u16*)(ws + A_ACT), FFN, (const u16*)(ws + W_F2), FFN, FFN, DM, 0, ws + A_F, DM, (u16*)lds, last); } break;
    case 20: phase_rowwise(p, false, (const u16*)(ws + A_F), p->in[I_NFPOST] + l * DM, l, 5, !last, p->in[I_NMPRE] + (last ? 0 : (l + 1) * DM), last ? l : l + 1, 0, 1, last); break;
  }
}

__global__ void __launch_bounds__(256, 2) mega_kernel(Params p_unused, int ph_lo, int ph_hi) {
  extern __shared__ __attribute__((aligned(16))) unsigned char lds[];
  __shared__ uint4 xb_words;
  cg::grid_group grid = cg::this_grid();
  PP pp = (PP)__builtin_amdgcn_kernarg_segment_ptr();
  if (threadIdx.x == 0) xb_words = make_uint4(0u, 0u, 0u, 0u);
  __syncthreads();
  XcdBarrier xb = xcd_barrier_post((unsigned*)(pp->ws + S_BAR), (volatile LAS unsigned*)&xb_words);
  int nsync = 0;
  if (ph_lo < 0) grid.sync();
  bool first = true;
  for (int ph = ph_lo; ph < ph_hi; ++ph) {
    if (phase_empty(ph)) continue;
    if (!first) {
      xcd_barrier(xb);
      ++nsync;
    }
    first = false;
    PP q = pp; asm volatile("" : "+s"(q));
    run_phase(q, ph, lds);
  }
}

extern "C" void kernel_launch(void* const* d_in, const int* in_sizes, int n_in, void* d_out, int out_size, void* d_ws, size_t ws_size, hipStream_t stream) {
  static int grid_blocks = 0;
  if (grid_blocks == 0) {
    if (n_in != N_IN || ws_size < WS_NEED) { fprintf(stderr, "kernel_launch: unexpected n_in %d / ws %zu\n", n_in, ws_size); grid_blocks = -1; return; }
    int dev = 0, cus = 0, per_cu = 0;
    hipGetDevice(&dev);
    hipDeviceGetAttribute(&cus, hipDeviceAttributeMultiprocessorCount, dev);
    if (hipFuncSetAttribute((const void*)mega_kernel, hipFuncAttributeMaxDynamicSharedMemorySize, LDS_BYTES) != hipSuccess) { fprintf(stderr, "hipFuncSetAttribute failed\n"); }
    hipOccupancyMaxActiveBlocksPerMultiprocessor(&per_cu, (const void*)mega_kernel, 256, LDS_BYTES);
    if (per_cu < 1) per_cu = 1;
    if (per_cu > 2) per_cu = 2;
    grid_blocks = cus * per_cu;
    fprintf(stderr, "kernel_launch: cus %d per_cu %d grid %d\n", cus, per_cu, grid_blocks);
  }
  if (grid_blocks < 0) return;
  Params p{};
  for (int i = 0; i < N_IN; ++i) p.in[i] = (const float*)d_in[i];
  p.out = (float*)d_out; p.ws = (unsigned char*)d_ws;
  if (hipMemsetAsync((unsigned char*)d_ws + S_BAR, 0, 16384, stream) != hipSuccess) { fprintf(stderr, "memset of barrier words failed\n"); return; }
#if MEGA
  int lo = 0, hi = 2 * NPH;
  void* args[] = {&p, &lo, &hi};
  hipError_t e = hipLaunchCooperativeKernel((const void*)mega_kernel, dim3(grid_blocks), dim3(256), args, LDS_BYTES, stream);
  if (e != hipSuccess) fprintf(stderr, "cooperative launch failed: %s\n", hipGetErrorString(e));
#else
  for (int ph = 0; ph < 2 * NPH; ++ph) {
    if (phase_empty(ph)) continue;
    hipLaunchKernelGGL(mega_kernel, dim3(grid_blocks), dim3(256), LDS_BYTES, stream, p, ph, ph + 1);
  }
#endif
}
```

```cpp
#include <hip/hip_runtime.h>
#include <hip/hip_cooperative_groups.h>
#include <cstdio>
#include <cstdint>
namespace cg = cooperative_groups;

#ifndef MEGA
#define MEGA 1
#endif

#define DI __device__ __forceinline__
typedef unsigned short u16;
typedef __attribute__((ext_vector_type(8))) short bf16x8;
typedef __attribute__((ext_vector_type(16))) float f32x16;
typedef __attribute__((ext_vector_type(4))) unsigned U4;
typedef __attribute__((ext_vector_type(2))) unsigned U2;
typedef __attribute__((ext_vector_type(4))) float F4;
typedef __attribute__((ext_vector_type(2))) float F2;
__device__ __forceinline__ U4 mku4(unsigned a, unsigned b, unsigned c, unsigned d) { U4 v = {a, b, c, d}; return v; }
__device__ __forceinline__ U2 mku2(unsigned a, unsigned b) { U2 v = {a, b}; return v; }
__device__ __forceinline__ F4 mkf4(float a, float b, float c, float d) { F4 v = {a, b, c, d}; return v; }
__device__ __forceinline__ F2 mkf2(float a, float b) { F2 v = {a, b}; return v; }
#define MFMA(a, b, c) __builtin_amdgcn_mfma_f32_32x32x16_bf16((a), (b), (c), 0, 0, 0)

constexpr int NB = 4, SEQ = 8192, DM = 1024, CTX = 256, TT = SEQ + CTX, ROWS = NB * TT;
constexpr int IN_COLS = 9424, OFF_DA = 0, OFF_SSD = 1536, OFF_MLA = 3088, OFF_HY = 3792, OFF_GATE = 5328;
constexpr int FFN = 2816;
constexpr float EPS = 1e-6f;
constexpr int NCH = TT / 128;
constexpr int FN = 8192;

enum { I_X = 0, I_C, I_CTX, I_CCTX, I_MODW, I_MODB, I_NMPRE, I_NMPOST, I_NFPRE, I_NFPOST, I_WIN, I_DALAM, I_DASUB,
       I_SCW, I_SCB, I_SALOG, I_SDTB, I_SD, I_SNORM, I_MQN, I_WUQ, I_MKVN, I_WUKV, I_HCW, I_HCB, I_HW1, I_HB1, I_HF1,
       I_HW2, I_HB2, I_HF2, I_HW3, I_HBIAS, I_WBDA, I_WBSSD, I_WBMLA, I_WBHY, I_WOUT, I_W1, I_W3, I_W2, N_IN };

struct Params { const float* in[N_IN]; float* out; unsigned char* ws; };
typedef const __attribute__((address_space(4))) Params* PP;

constexpr size_t MiB = 1048576;
constexpr size_t W_WIN = 0;
constexpr size_t W_UQ = W_WIN + (size_t)9552 * 1024 * 2;
constexpr size_t W_UKV = W_UQ + (size_t)768 * 384 * 2;
constexpr size_t W_BR = W_UKV + (size_t)1024 * 256 * 2;
constexpr size_t W_OUT = W_BR + (size_t)4 * 1024 * 512 * 2;
constexpr size_t W_F1 = W_OUT + (size_t)1024 * 1024 * 2;
constexpr size_t W_F3 = W_F1 + (size_t)2816 * 1024 * 2;
constexpr size_t W_F2 = W_F3 + (size_t)2816 * 1024 * 2;
constexpr size_t W_END = W_F2 + (size_t)2816 * 1024 * 2;
static_assert(W_END <= 43 * MiB, "weights region");
constexpr size_t S_BASE = 43 * MiB;
constexpr size_t S_MOD = S_BASE;
constexpr size_t S_MODP = S_MOD + (size_t)2 * 5 * 6144 * 4;
constexpr size_t S_W2 = S_MODP + (size_t)2 * 16 * 5 * 6144 * 4;
constexpr size_t S_HID = S_W2 + (size_t)8192 * 8;
constexpr size_t S_HIDC = S_HID + (size_t)8192 * 64 * 4;
constexpr size_t S_DT = S_HIDC + (size_t)256 * 64 * 4;
constexpr size_t S_CDEC = S_DT + (size_t)ROWS * 16 * 4;
constexpr size_t S_CTR = S_CDEC + (size_t)2 * NB * NCH * 8 * 4;
constexpr size_t S_XCTX = S_CTR + 256;
constexpr size_t S_BAR = S_XCTX + (size_t)NB * CTX * DM * 4;
constexpr size_t S_END = S_BAR + 16384;
static_assert(S_END <= 57 * MiB, "small region");
constexpr size_t H_OFF = 57 * MiB;
constexpr size_t AR = 123 * MiB;
constexpr size_t A_OHY = AR + 356 * MiB, A_OMLA = AR + 323 * MiB, A_DAQ = AR + 290 * MiB;
constexpr size_t A_PTHY = AR, A_GSPEC = AR + 99 * MiB, A_ZSAVE = AR + 227 * MiB, A_YSAVE = AR + 259 * MiB;
constexpr size_t A_MLAQ = AR, A_DAK = AR + 99 * MiB / 2, A_DAVT = A_DAK + 33 * MiB, A_MLAC = A_DAVT + 33 * MiB;
constexpr size_t A_MLAKN = A_MLAC + 46 * MiB, A_MLAVT = A_MLAKN + 33 * MiB;
static_assert(A_MLAVT + 33 * MiB <= A_DAQ, "round A");
constexpr size_t A_SSDZX = AR, A_STF = AR + 99 * MiB, A_STB = A_STF + 66 * MiB, A_YBUF = A_STB + 66 * MiB;
constexpr size_t A_XSACT = AR + 132 * MiB, A_BCACT = AR + 198 * MiB;
constexpr size_t A_MIXED = AR + 99 * MiB, A_YOUT = A_MIXED + 66 * MiB;
constexpr size_t A_ACT = AR, A_F = AR + 182 * MiB;
constexpr size_t WS_NEED = 512 * MiB;

constexpr int LDS_BYTES = 73728;

DI int get_tid() { int t = threadIdx.x; asm volatile("" : "+v"(t)); return t; }
DI int get_bid() { int t = blockIdx.x; asm volatile("" : "+s"(t)); return t; }
typedef __attribute__((ext_vector_type(2))) __bf16 B2;
DI u16 f2bf(float x) { __bf16 b = (__bf16)x; return __builtin_bit_cast(u16, b); }
DI float bf2f(u16 h) { return __uint_as_float(((unsigned)h) << 16); }
DI unsigned pack2(float a, float b) { F2 v = {a, b}; B2 r = __builtin_convertvector(v, B2); return __builtin_bit_cast(unsigned, r); }
DI float lo2f(unsigned v) { return __uint_as_float(v << 16); }
DI float hi2f(unsigned v) { return __uint_as_float(v & 0xffff0000u); }
DI void unpack8(const U4& v, float (&x)[8]) {
  x[0] = lo2f(v.x); x[1] = hi2f(v.x); x[2] = lo2f(v.y); x[3] = hi2f(v.y);
  x[4] = lo2f(v.z); x[5] = hi2f(v.z); x[6] = lo2f(v.w); x[7] = hi2f(v.w);
}
DI U4 pack8(const float (&x)[8]) { return mku4(pack2(x[0], x[1]), pack2(x[2], x[3]), pack2(x[4], x[5]), pack2(x[6], x[7])); }
DI float wave_sum(float v) { for (int o = 32; o > 0; o >>= 1) v += __shfl_xor(v, o); return v; }
DI float siluf(float x) { return x / (1.f + __expf(-x)); }
DI float sigmoidf(float x) { return 1.f / (1.f + __expf(-x)); }
DI float fexp2(float x) { return __builtin_amdgcn_exp2f(x); }
DI int crow(int t, int h) { return (t & 3) + 8 * (t >> 2) + 4 * h; }
DI f32x16 zero16() { f32x16 z; for (int i = 0; i < 16; ++i) z[i] = 0.f; return z; }

DI const float* xrow_in(PP p, int r, bool first) {
  int b = r / TT, t = r - b * TT;
  if (first) return t < CTX ? p->in[I_CTX] + ((size_t)b * CTX + t) * DM : p->in[I_X] + ((size_t)b * SEQ + (t - CTX)) * DM;
  return t < CTX ? (const float*)(p->ws + S_XCTX) + ((size_t)b * CTX + t) * DM : p->out + ((size_t)b * SEQ + (t - CTX)) * DM;
}
DI float* xrow_out(PP p, int r) {
  int b = r / TT, t = r - b * TT;
  return t < CTX ? (float*)(p->ws + S_XCTX) + ((size_t)b * CTX + t) * DM : p->out + ((size_t)b * SEQ + (t - CTX)) * DM;
}
DI const float* modvec(PP p, int l, int s, int idx) { return (const float*)(p->ws + S_MOD) + ((size_t)(l * 5 + s) * 6 + idx) * DM; }

constexpr int GL = 72;
template <int MT, bool SWAP = true>
DI void gemm_acc(f32x16 (&acc)[MT][2], const u16* __restrict__ A, int lda, const u16* __restrict__ Bt, int ldb, int K, u16* lds) {
  const int tid = get_tid(), lane = tid & 63, w = tid >> 6, wm = w >> 1, wn = w & 1, r = lane & 31, h = lane >> 5;
  constexpr int STG = 256 * GL;
  U4 ra[2 * MT], rb[4];
  const int lrow = tid >> 3, lkc = (tid & 7) * 8;
  const u16* Ap = A + (size_t)lrow * lda + lkc; const u16* Bp = Bt + (size_t)lrow * ldb + lkc;
  const unsigned a32 = 32u * (unsigned)lda, b32 = 32u * (unsigned)ldb;
#pragma unroll
  for (int i = 0; i < 2 * MT; ++i) ra[i] = *(const U4*)(Ap + i * a32);
#pragma unroll
  for (int i = 0; i < 4; ++i) rb[i] = *(const U4*)(Bp + i * b32);
  __syncthreads();
  {
    u16* As = lds; u16* Bs = lds + 128 * GL;
#pragma unroll
    for (int i = 0; i < 2 * MT; ++i) *(U4*)(As + (lrow + 32 * i) * GL + lkc) = ra[i];
#pragma unroll
    for (int i = 0; i < 4; ++i) *(U4*)(Bs + (lrow + 32 * i) * GL + lkc) = rb[i];
  }
  if (K > 64) {
#pragma unroll
    for (int i = 0; i < 2 * MT; ++i) ra[i] = *(const U4*)(Ap + 64 + i * a32);
#pragma unroll
    for (int i = 0; i < 4; ++i) rb[i] = *(const U4*)(Bp + 64 + i * b32);
  }
  __syncthreads();
  const int KT = K >> 6;
  for (int kt = 0; kt < KT; ++kt) {
    const u16* As = lds + (kt & 1) * STG; const u16* Bs = As + 128 * GL;
    if (kt + 1 < KT) {
      u16* An = lds + ((kt + 1) & 1) * STG; u16* Bn = An + 128 * GL;
#pragma unroll
      for (int i = 0; i < 2 * MT; ++i) *(U4*)(An + (lrow + 32 * i) * GL + lkc) = ra[i];
#pragma unroll
      for (int i = 0; i < 4; ++i) *(U4*)(Bn + (lrow + 32 * i) * GL + lkc) = rb[i];
      if (kt + 2 < KT) {
        const int ko = (kt + 2) * 64;
#pragma unroll
        for (int i = 0; i < 2 * MT; ++i) ra[i] = *(const U4*)(Ap + ko + i * a32);
#pragma unroll
        for (int i = 0; i < 4; ++i) rb[i] = *(const U4*)(Bp + ko + i * b32);
      }
    }
#pragma unroll
    for (int ks = 0; ks < 4; ++ks) {
      bf16x8 a[MT], b[2];
#pragma unroll
      for (int i = 0; i < MT; ++i) a[i] = *(const bf16x8*)(As + (wm * 32 * MT + i * 32 + r) * GL + ks * 16 + h * 8);
#pragma unroll
      for (int j = 0; j < 2; ++j) b[j] = *(const bf16x8*)(Bs + (wn * 64 + j * 32 + r) * GL + ks * 16 + h * 8);
#pragma unroll
      for (int i = 0; i < MT; ++i)
#pragma unroll
        for (int j = 0; j < 2; ++j) acc[i][j] = SWAP ? MFMA(b[j], a[i], acc[i][j]) : MFMA(a[i], b[j], acc[i][j]);
    }
    __syncthreads();
  }
}
template <int MT> DI void zero_acc(f32x16 (&acc)[MT][2]) { for (int i = 0; i < MT; ++i) for (int j = 0; j < 2; ++j) acc[i][j] = zero16(); }

template <int MT, int NT>
DI void wave_mma(f32x16 (&acc)[MT][NT], const u16* A, int lda, const u16* Bt, int ldb, int K) {
  const int lane = get_tid() & 63, r = lane & 31, h = lane >> 5;
  for (int k = 0; k < K; k += 16) {
    bf16x8 a[MT], b[NT];
#pragma unroll
    for (int i = 0; i < MT; ++i) a[i] = *(const bf16x8*)(A + (i * 32 + r) * lda + k + h * 8);
#pragma unroll
    for (int j = 0; j < NT; ++j) b[j] = *(const bf16x8*)(Bt + (j * 32 + r) * ldb + k + h * 8);
#pragma unroll
    for (int i = 0; i < MT; ++i)
#pragma unroll
      for (int j = 0; j < NT; ++j) acc[i][j] = MFMA(a[i], b[j], acc[i][j]);
  }
}

template <int MT>
DI void store_tile_bf16(const f32x16 (&acc)[MT][2], u16* dst, size_t ldc, int row0, int col0, int ncols) {
  const int lane = get_tid() & 63, w = get_tid() >> 6, wm = w >> 1, wn = w & 1, r = lane & 31, h = lane >> 5;
#pragma unroll
  for (int i = 0; i < MT; ++i) {
    u16* rowp = dst + (size_t)(row0 + wm * 32 * MT + i * 32 + r) * ldc;
#pragma unroll
    for (int j = 0; j < 2; ++j)
#pragma unroll
      for (int g = 0; g < 4; ++g) {
        int col = col0 + wn * 64 + j * 32 + 8 * g + 4 * h;
        if (col < ncols) *(U2*)(rowp + col) = mku2(pack2(acc[i][j][4 * g], acc[i][j][4 * g + 1]), pack2(acc[i][j][4 * g + 2], acc[i][j][4 * g + 3]));
      }
  }
}
DI void store_tile_f32(const f32x16 (&acc)[2][2], float* dst, size_t ldc, int row0, int col0, int ncols) {
  const int lane = get_tid() & 63, w = get_tid() >> 6, wm = w >> 1, wn = w & 1, r = lane & 31, h = lane >> 5;
#pragma unroll
  for (int i = 0; i < 2; ++i) {
    float* rowp = dst + (size_t)(row0 + wm * 64 + i * 32 + r) * ldc;
#pragma unroll
    for (int j = 0; j < 2; ++j)
#pragma unroll
      for (int g = 0; g < 4; ++g) {
        int col = col0 + wn * 64 + j * 32 + 8 * g + 4 * h;
        if (col < ncols) *(F4*)(rowp + col) = mkf4(acc[i][j][4 * g], acc[i][j][4 * g + 1], acc[i][j][4 * g + 2], acc[i][j][4 * g + 3]);
      }
  }
}
DI void store_tile_T(const f32x16 (&acc)[2][2], u16* dstT, int ncolsT, int row0, int col0) {
  const int lane = get_tid() & 63, w = get_tid() >> 6, wm = w >> 1, wn = w & 1, r = lane & 31, h = lane >> 5;
  const int b = row0 / TT, t0 = row0 - b * TT;
#pragma unroll
  for (int i = 0; i < 2; ++i)
#pragma unroll
    for (int j = 0; j < 2; ++j) {
      int col = col0 + wn * 64 + j * 32 + r;
      u16* base = dstT + ((size_t)b * ncolsT + col) * TT + t0 + wm * 64 + i * 32 + 4 * h;
#pragma unroll
      for (int g = 0; g < 4; ++g) {
        U2 v = mku2(pack2(acc[i][j][4 * g], acc[i][j][4 * g + 1]), pack2(acc[i][j][4 * g + 2], acc[i][j][4 * g + 3]));
        *(U2*)(base + 8 * g) = v;
      }
    }
}

struct TileIter { int off; };
#define FOR_TILES(IT, NT_, VAR) for (int VAR = (int)(((long)get_bid() - (IT).off % (int)gridDim.x + gridDim.x) % gridDim.x); VAR < (NT_); VAR += gridDim.x)

DI void conv_job(TileIter& it, const float* src, int K, int N, u16* dst, float* tile  ) {
  const int tid = get_tid();
  const int nkt = K / 64, nnt = (N + 63) / 64, ntile = nkt * nnt;
  FOR_TILES(it, ntile, ti) {
    int kt = ti % nkt, nt = ti / nkt;
    __syncthreads();
#pragma unroll
    for (int i = 0; i < 4; ++i) {
      int kr = (tid >> 4) + 16 * i, nc = (tid & 15) * 4;
      int n = nt * 64 + nc;
      F4 v = mkf4(0.f, 0.f, 0.f, 0.f);
      if (n < N) v = *(const F4*)(src + (size_t)(kt * 64 + kr) * N + n);
      tile[kr * 65 + nc] = v.x; tile[kr * 65 + nc + 1] = v.y; tile[kr * 65 + nc + 2] = v.z; tile[kr * 65 + nc + 3] = v.w;
    }
    __syncthreads();
    int nl = tid >> 2, kc = (tid & 3) * 16;
    int n = nt * 64 + nl;
    if (n < N) {
      float x[8];
#pragma unroll
      for (int hlf = 0; hlf < 2; ++hlf) {
#pragma unroll
        for (int e = 0; e < 8; ++e) x[e] = tile[(kc + hlf * 8 + e) * 65 + nl];
        *(U4*)(dst + (size_t)n * K + kt * 64 + kc + hlf * 8) = pack8(x);
      }
    }
  }
  it.off += ntile;
}

DI void phase_conv(PP p, int l, unsigned char* lds) {
  float* tile = (float*)lds;
  unsigned char* ws = p->ws;
  TileIter it{0};
  conv_job(it, p->in[I_WIN] + (size_t)l * DM * IN_COLS, DM, IN_COLS, (u16*)(ws + W_WIN), tile);
  conv_job(it, p->in[I_WUQ] + (size_t)l * 384 * 768, 384, 768, (u16*)(ws + W_UQ), tile);
  conv_job(it, p->in[I_WUKV] + (size_t)l * 256 * 1024, 256, 1024, (u16*)(ws + W_UKV), tile);
  for (int i = 0; i < 4; ++i) conv_job(it, p->in[I_WBDA + i] + (size_t)l * 512 * 1024, 512, 1024, (u16*)(ws + W_BR) + (size_t)i * 1024 * 512, tile);
  conv_job(it, p->in[I_WOUT] + (size_t)l * DM * DM, DM, DM, (u16*)(ws + W_OUT), tile);
  conv_job(it, p->in[I_W1] + (size_t)l * DM * FFN, DM, FFN, (u16*)(ws + W_F1), tile);
  conv_job(it, p->in[I_W3] + (size_t)l * DM * FFN, DM, FFN, (u16*)(ws + W_F3), tile);
  conv_job(it, p->in[I_W2] + (size_t)l * FFN * DM, FFN, DM, (u16*)(ws + W_F2), tile);
  const int tid = get_tid();
  if (get_bid() == 0 && tid < 64) ((int*)(ws + S_CTR))[tid] = 0;
  if (l == 0) {
    F2* W2 = (F2*)(ws + S_W2);
    for (int m = get_bid() * 256 + tid; m < 8192; m += gridDim.x * 256) {
      float sn, cs; sincospif((float)m * (1.f / 8192.f), &sn, &cs);
      W2[m] = mkf2(cs, -sn);
    }
    float* modp = (float*)(ws + S_MODP);
    for (int itx = get_bid(); itx < 2 * 24 * 16; itx += gridDim.x) {
      int l2 = itx / 384, rem = itx % 384, cb = rem / 16, ks = rem % 16;
      int col = cb * 256 + tid;
      const float* mw = p->in[I_MODW] + (size_t)l2 * DM * 6144;
      float acc[5] = {0.f, 0.f, 0.f, 0.f, 0.f};
#pragma unroll 4
      for (int k = ks * 64; k < ks * 64 + 64; ++k) {
        float wv = mw[(size_t)k * 6144 + col];
#pragma unroll
        for (int s = 0; s < 5; ++s) { float cv = (s < 4) ? p->in[I_C][s * DM + k] : p->in[I_CCTX][k]; acc[s] += siluf(cv) * wv; }
      }
#pragma unroll
      for (int s = 0; s < 5; ++s) modp[(((size_t)l2 * 16 + ks) * 5 + s) * 6144 + col] = acc[s];
    }
  }
  {
    __syncthreads();
    float* feats = (float*)lds;
    float* h1 = feats + 4 * 36;
    const float* w1 = p->in[I_HW1] + (size_t)l * 33 * 64; const float* b1 = p->in[I_HB1] + l * 64; const float* f1 = p->in[I_HF1] + l * 64;
    const float* w2 = p->in[I_HW2] + (size_t)l * 64 * 64; const float* b2 = p->in[I_HB2] + l * 64; const float* f2 = p->in[I_HF2] + l * 64;
    const int nitem = 2048 + (l == 0 ? 64 : 0);
    for (int itx = get_bid(); itx < nitem; itx += gridDim.x) {
      const bool isc = itx >= 2048;
      const int n = isc ? 256 : 8192;
      const int tl = tid >> 6, j = tid & 63;
      const int t = (isc ? (itx - 2048) : itx) * 4 + tl;
      __syncthreads();
      if (j < 33) {
        float f;
        if (j == 0) f = (float)t / (float)(n - 1);
        else {
          int bi = (j - 1) & 15;
          float band = 1e-4f + (float)bi * ((15.0f - 1e-4f) / 15.0f);
          float xx = 2.f * ((float)t / (float)n) * band;
          float sn, cs; sincospif(xx, &sn, &cs);
          f = (j <= 16) ? cs : -sn;
        }
        feats[tl * 36 + j] = f;
      }
      __syncthreads();
      float a = b1[j];
#pragma unroll 3
      for (int i = 0; i < 33; ++i) a += feats[tl * 36 + i] * w1[i * 64 + j];
      h1[tl * 64 + j] = sinf(f1[j] * a);
      __syncthreads();
      float a2 = b2[j];
#pragma unroll 4
      for (int k = 0; k < 64; ++k) a2 += h1[tl * 64 + k] * w2[k * 64 + j];
      const float hv2 = sinf(f2[j] * a2);
      if (isc) ((float*)(ws + S_HIDC))[(size_t)t * 64 + j] = hv2; else ((u16*)(ws + S_HID))[(size_t)t * 64 + j] = f2bf(hv2);
    }
  }
}

DI void phase_modfin(PP p) {
  float* mod = (float*)(p->ws + S_MOD); const float* modp = (const float*)(p->ws + S_MODP);
  for (int i = get_bid() * 256 + get_tid(); i < 2 * 5 * 6144; i += gridDim.x * 256) {
    int l2 = i / (5 * 6144), rem = i % (5 * 6144), s = rem / 6144, col = rem % 6144;
    float a = p->in[I_MODB][l2 * 6144 + col];
#pragma unroll 4
    for (int ks = 0; ks < 16; ++ks) a += modp[(((size_t)l2 * 16 + ks) * 5 + s) * 6144 + col];
    mod[((size_t)(l2 * 5 + s)) * 6144 + col] = a;
  }
}

DI void phase_rowwise(PP p, bool first, const u16* src, const float* g_post, int l_res, int gate_idx,
                      bool write_h, const float* g_pre, int l_mod, int shift_idx, int scale_idx, bool skip_ctx) {
  const int lane = get_tid() & 63, w = get_tid() >> 6;
  u16* H = (u16*)(p->ws + H_OFF);
  for (int r = get_bid() * 4 + w; r < ROWS; r += gridDim.x * 4) {
    int b = r / TT, t = r - b * TT;
    if (skip_ctx && t < CTX) continue;
    int s = t < CTX ? 4 : b;
    const float* xin = xrow_in(p, r, first);
    float x[16];
#pragma unroll
    for (int i = 0; i < 4; ++i) { F4 v = *(const F4*)(xin + i * 256 + lane * 4); x[4 * i] = v.x; x[4 * i + 1] = v.y; x[4 * i + 2] = v.z; x[4 * i + 3] = v.w; }
    if (src) {
      float y[16]; float ss = 0.f;
#pragma unroll
      for (int i = 0; i < 4; ++i) { U2 v = *(const U2*)(src + (size_t)r * DM + i * 256 + lane * 4);
        y[4 * i] = lo2f(v.x); y[4 * i + 1] = hi2f(v.x); y[4 * i + 2] = lo2f(v.y); y[4 * i + 3] = hi2f(v.y); }
#pragma unroll
      for (int i = 0; i < 16; ++i) ss += y[i] * y[i];
      ss = wave_sum(ss);
      float rstd = rsqrtf(ss * (1.f / DM) + EPS);
      const float* gate = modvec(p, l_res, s, gate_idx);
      float* xo = xrow_out(p, r);
#pragma unroll
      for (int i = 0; i < 4; ++i) {
        int k = i * 256 + lane * 4;
        F4 g = *(const F4*)(g_post + k); F4 gt = *(const F4*)(gate + k);
        x[4 * i] += gt.x * (y[4 * i] * rstd * g.x); x[4 * i + 1] += gt.y * (y[4 * i + 1] * rstd * g.y);
        x[4 * i + 2] += gt.z * (y[4 * i + 2] * rstd * g.z); x[4 * i + 3] += gt.w * (y[4 * i + 3] * rstd * g.w);
        *(F4*)(xo + k) = mkf4(x[4 * i], x[4 * i + 1], x[4 * i + 2], x[4 * i + 3]);
      }
    }
    if (write_h) {
      float ss = 0.f;
#pragma unroll
      for (int i = 0; i < 16; ++i) ss += x[i] * x[i];
      ss = wave_sum(ss);
      float rstd = rsqrtf(ss * (1.f / DM) + EPS);
      const float* sh = modvec(p, l_mod, s, shift_idx); const float* sc = modvec(p, l_mod, s, scale_idx);
#pragma unroll
      for (int i = 0; i < 4; ++i) {
        int k = i * 256 + lane * 4;
        F4 g = *(const F4*)(g_pre + k); F4 a = *(const F4*)(sh + k); F4 c = *(const F4*)(sc + k);
        float h0 = x[4 * i] * rstd * g.x * (1.f + c.x) + a.x, h1 = x[4 * i + 1] * rstd * g.y * (1.f + c.y) + a.y;
        float h2 = x[4 * i + 2] * rstd * g.z * (1.f + c.z) + a.z, h3 = x[4 * i + 3] * rstd * g.w * (1.f + c.w) + a.w;
        *(U2*)(H + (size_t)r * DM + k) = mku2(pack2(h0, h1), pack2(h2, h3));
      }
    }
  }
}

DI void gemm_job(TileIter& it, const u16* A, int lda, const u16* Bt, int ldb, int K, int N, int mode, void* dst, int ldc, u16* lds, bool skipc = false) {
  const int ntn = (N + 127) / 128, ntile = (skipc ? NB * 64 : ROWS / 128) * ntn;
  FOR_TILES(it, ntile, ti) {
    int tm = ti / ntn, tn = ti % ntn;
    if (skipc) tm = NCH * (tm >> 6) + 2 + (tm & 63);
    f32x16 acc[2][2]; zero_acc<2>(acc);
    if (mode == 2) {
      gemm_acc<2, false>(acc, A + (size_t)tm * 128 * lda, lda, Bt + (size_t)tn * 128 * ldb, ldb, K, lds);
      store_tile_T(acc, (u16*)dst, N, tm * 128, tn * 128);
    } else {
      gemm_acc<2, true>(acc, A + (size_t)tm * 128 * lda, lda, Bt + (size_t)tn * 128 * ldb, ldb, K, lds);
      if (mode == 0) store_tile_bf16<2>(acc, (u16*)dst, ldc, tm * 128, tn * 128, N);
      else store_tile_f32(acc, (float*)dst, ldc, tm * 128, tn * 128, N);
    }
  }
  it.off += ntile;
}

DI void phase_rope(PP p, int l) {
  const int lane = get_tid() & 63, w = get_tid() >> 6;
  u16* daq = (u16*)(p->ws + A_DAQ); u16* dak = (u16*)(p->ws + A_DAK); u16* mc = (u16*)(p->ws + A_MLAC);
  const float* qn = p->in[I_MQN] + l * 384; const float* kvn = p->in[I_MKVN] + l * 256;
  const float L2_10000 = 13.287712379549449f;
  for (int r = get_bid() * 4 + w; r < ROWS; r += gridDim.x * 4) {
    int b = r / TT, t = r - b * TT;
    const bool lat = t >= CTX;
    const int pos = t - CTX; const float prow = (float)(pos >> 6), pcol = (float)(pos & 63);
    if (lat) {
      int v = lane >> 3, i0 = (lane & 7) * 4;
      float cs[4], sn[4];
#pragma unroll
      for (int e = 0; e < 4; ++e) { int i = i0 + e; float inv = exp2f(-(float)(i & 15) * (1.f / 16.f) * L2_10000); float ang = (i < 16 ? prow : pcol) * inv; sincosf(ang, &sn[e], &cs[e]); }
#pragma unroll
      for (int which = 0; which < 2; ++which) {
        u16* base = (which ? dak : daq) + (size_t)r * 512 + v * 64 + i0;
        U2 a = *(U2*)base, c = *(U2*)(base + 32);
        float x1[4] = {lo2f(a.x), hi2f(a.x), lo2f(a.y), hi2f(a.y)}, x2[4] = {lo2f(c.x), hi2f(c.x), lo2f(c.y), hi2f(c.y)};
        float o1[4], o2[4];
#pragma unroll
        for (int e = 0; e < 4; ++e) { o1[e] = x1[e] * cs[e] - x2[e] * sn[e]; o2[e] = x2[e] * cs[e] + x1[e] * sn[e]; }
        *(U2*)base = mku2(pack2(o1[0], o1[1]), pack2(o1[2], o1[3]));
        *(U2*)(base + 32) = mku2(pack2(o2[0], o2[1]), pack2(o2[2], o2[3]));
      }
    }
    u16* row = mc + (size_t)r * 704;
    {
      float x[6]; float ss = 0.f;
#pragma unroll
      for (int i = 0; i < 3; ++i) { unsigned v = *(unsigned*)(row + i * 128 + lane * 2); x[2 * i] = lo2f(v); x[2 * i + 1] = hi2f(v); }
#pragma unroll
      for (int i = 0; i < 6; ++i) ss += x[i] * x[i];
      ss = wave_sum(ss); float rstd = rsqrtf(ss * (1.f / 384.f) + EPS);
#pragma unroll
      for (int i = 0; i < 3; ++i) { int k = i * 128 + lane * 2; *(unsigned*)(row + k) = pack2(x[2 * i] * rstd * qn[k], x[2 * i + 1] * rstd * qn[k + 1]); }
    }
    {
      float x[4]; float ss = 0.f;
#pragma unroll
      for (int i = 0; i < 2; ++i) { unsigned v = *(unsigned*)(row + 384 + i * 128 + lane * 2); x[2 * i] = lo2f(v); x[2 * i + 1] = hi2f(v); }
#pragma unroll
      for (int i = 0; i < 4; ++i) ss += x[i] * x[i];
      ss = wave_sum(ss); float rstd = rsqrtf(ss * (1.f / 256.f) + EPS);
#pragma unroll
      for (int i = 0; i < 2; ++i) { int k = i * 128 + lane * 2; *(unsigned*)(row + 384 + k) = pack2(x[2 * i] * rstd * kvn[k], x[2 * i + 1] * rstd * kvn[k + 1]); }
    }
    if (lat && lane < 32) {
      int i = lane; float inv = exp2f(-(float)(i & 15) * (1.f / 16.f) * L2_10000); float ang = (i < 16 ? prow : pcol) * inv; float sn, cs; sincosf(ang, &sn, &cs);
      float x1 = bf2f(row[640 + i]), x2 = bf2f(row[640 + 32 + i]);
      row[640 + i] = f2bf(x1 * cs - x2 * sn); row[640 + 32 + i] = f2bf(x2 * cs + x1 * sn);
    }
  }
}

template <int DQK>
struct AttnState { f32x16 ot[4]; float m, l; };

template <int DQK, int QR>
DI void attn_tile(AttnState<DQK>& st, const bf16x8 (&q)[QR], const u16* qlds, const u16* Ks, int kcol0, const u16* Vs) {
  constexpr int KL = (DQK == 64 ? 128 : 192) + 8;
  const int lane = get_tid() & 63, r = lane & 31, h = lane >> 5;
#pragma unroll
  for (int kb = 0; kb < 2; ++kb) {
    f32x16 s = zero16();
#pragma unroll
    for (int ks = 0; ks < DQK / 16; ++ks) {
      bf16x8 a = *(const bf16x8*)(Ks + (kb * 32 + r) * KL + kcol0 + ks * 16 + h * 8);
      bf16x8 qv;
      if (ks < QR) qv = q[ks < QR ? ks : 0]; else qv = *(const bf16x8*)(qlds + (ks - QR) * 16);
      s = MFMA(a, qv, s);
    }
    if (DQK == 192) __builtin_amdgcn_sched_barrier(0);
    float mx = s[0];
#pragma unroll
    for (int t = 1; t < 16; ++t) mx = fmaxf(mx, s[t]);
    mx = fmaxf(mx, __shfl_xor(mx, 32));
    const float mnew = fmaxf(st.m, mx);
    const float alpha = fexp2(st.m - mnew);
    st.m = mnew;
    float ps = 0.f;
#pragma unroll
    for (int t = 0; t < 16; ++t) { float pv = fexp2(s[t] - mnew); s[t] = pv; ps += pv; }
    st.l = st.l * alpha + ps;
    if (__builtin_amdgcn_ballot_w64(alpha != 1.f) != 0) {
#pragma unroll
      for (int eb = 0; eb < 4; ++eb)
#pragma unroll
        for (int t = 0; t < 16; ++t) st.ot[eb][t] *= alpha;
    }
#pragma unroll
    for (int s2 = 0; s2 < 2; ++s2) {
      unsigned pk[4];
#pragma unroll
      for (int j = 0; j < 4; ++j) pk[j] = pack2(s[8 * s2 + 2 * j], s[8 * s2 + 2 * j + 1]);
      bf16x8 pf = __builtin_bit_cast(bf16x8, mku4(pk[0], pk[1], pk[2], pk[3]));
#pragma unroll
      for (int eb = 0; eb < 4; ++eb) {
        const u16* vp = Vs + (eb * 32 + r) * 72 + kb * 32 + 16 * s2 + 4 * h;
        U2 lo = *(const U2*)vp, hi = *(const U2*)(vp + 8);
        bf16x8 vf = __builtin_bit_cast(bf16x8, mku4(lo.x, lo.y, hi.x, hi.y));
        st.ot[eb] = MFMA(vf, pf, st.ot[eb]);
      }
    }
    if (DQK == 192) __builtin_amdgcn_sched_barrier(0);
  }
}

template <int DQK, int QR>
DI void attn_tile64(AttnState<DQK>& st, const bf16x8 (&q)[QR], const u16* Ks, int kcol0, const u16* Vs) {
  constexpr int KL = (DQK == 64 ? 128 : 192) + 8;
  const int lane = get_tid() & 63, r = lane & 31, h = lane >> 5;
  f32x16 s[2];
#pragma unroll
  for (int kb = 0; kb < 2; ++kb) {
    s[kb] = zero16();
#pragma unroll
    for (int ks = 0; ks < DQK / 16; ++ks) {
      bf16x8 a = *(const bf16x8*)(Ks + (kb * 32 + r) * KL + kcol0 + ks * 16 + h * 8);
      s[kb] = MFMA(a, q[ks], s[kb]);
    }
  }
  float mx = s[0][0];
#pragma unroll
  for (int kb = 0; kb < 2; ++kb)
#pragma unroll
    for (int t = 0; t < 16; ++t) mx = fmaxf(mx, s[kb][t]);
  mx = fmaxf(mx, __shfl_xor(mx, 32));
  const float mnew = fmaxf(st.m, mx);
  const float alpha = fexp2(st.m - mnew);
  st.m = mnew;
  float ps = 0.f;
#pragma unroll
  for (int kb = 0; kb < 2; ++kb)
#pragma unroll
    for (int t = 0; t < 16; ++t) { float pv = fexp2(s[kb][t] - mnew); s[kb][t] = pv; ps += pv; }
  st.l = st.l * alpha + ps;
  if (__builtin_amdgcn_ballot_w64(alpha != 1.f) != 0) {
#pragma unroll
    for (int eb = 0; eb < 4; ++eb)
#pragma unroll
      for (int t = 0; t < 16; ++t) st.ot[eb][t] *= alpha;
  }
#pragma unroll
  for (int kb = 0; kb < 2; ++kb)
#pragma unroll
    for (int s2 = 0; s2 < 2; ++s2) {
      unsigned pk[4];
#pragma unroll
      for (int j = 0; j < 4; ++j) pk[j] = pack2(s[kb][8 * s2 + 2 * j], s[kb][8 * s2 + 2 * j + 1]);
      bf16x8 pf = __builtin_bit_cast(bf16x8, mku4(pk[0], pk[1], pk[2], pk[3]));
#pragma unroll
      for (int eb = 0; eb < 4; ++eb) {
        const u16* vp = Vs + (eb * 32 + r) * 72 + kb * 32 + 16 * s2 + 4 * h;
        U2 lo = *(const U2*)vp, hi = *(const U2*)(vp + 8);
        bf16x8 vf = __builtin_bit_cast(bf16x8, mku4(lo.x, lo.y, hi.x, hi.y));
        st.ot[eb] = MFMA(vf, pf, st.ot[eb]);
      }
    }
}

DI void phase_attn(PP p, int l, bool need_ctx, unsigned char* ldsb, int probe = 0) {
  const int tid = get_tid(), lane = tid & 63, w = tid >> 6, r = lane & 31, h = lane >> 5;
  unsigned char* ws = p->ws;
  const u16* mlaq = (const u16*)(ws + A_MLAQ); const u16* mlakn = (const u16*)(ws + A_MLAKN); const u16* mlavt = (const u16*)(ws + A_MLAVT);
  const u16* mlac = (const u16*)(ws + A_MLAC); u16* omla = (u16*)(ws + A_OMLA);
  u16* daq = (u16*)(ws + A_DAQ); const u16* dak = (const u16*)(ws + A_DAK); const u16* davt = (const u16*)(ws + A_DAVT);
  const float L2E = 1.4426950408889634f, L2_10000 = 13.287712379549449f;
  const int n_mla = NB * 66 * 4, n_da = NB * 132 * 4;
  int* ctr = (int*)(ws + S_CTR);
  int* sh_item = (int*)(ldsb + 72704);
  const int grp = get_bid() & 7;
  const int n_items = probe ? 128 : 384 + (need_ctx ? 12 : 0);
  for (;;) {
    __syncthreads();
    if (tid == 0) *sh_item = atomicAdd(ctr + grp + (probe ? 8 : 0), 1);
    __syncthreads();
    const int qi = *sh_item;
    if (qi >= n_items) break;
    int item;
    if (qi < 128) { int pr = grp + 8 * (qi >> 6), qb = 2 + (qi & 63); item = (pr >> 2) * 264 + qb * 4 + (pr & 3); }
    else if (qi < 384) { int q2 = qi - 128; int pr = grp + 8 * (q2 >> 7), qb = 4 + (q2 & 127); item = n_mla + (pr >> 2) * 528 + qb * 4 + (pr & 3); }
    else if (qi < 388) { int q2 = qi - 384; int pr = grp + 8 * (q2 >> 1), qb = q2 & 1; item = (pr >> 2) * 264 + qb * 4 + (pr & 3); }
    else { int q2 = qi - 388; int pr = grp + 8 * (q2 >> 2), qb = q2 & 3; item = n_mla + (pr >> 2) * 528 + qb * 4 + (pr & 3); }
    if (item < n_mla) {
      const int b = item / 264, rem = item % 264, qb = rem >> 2, hd = rem & 3;
      const int nk = qb < 2 ? CTX : TT;
      constexpr int KL = 200;
      u16* Ks = (u16*)ldsb; u16* Vs = Ks + 64 * KL;
      const int tq = qb * 128 + w * 32 + r; const size_t qrow = (size_t)b * TT + tq;
      bf16x8 q[12];
      const u16* qlds = nullptr;
      {
        const float sc = 0.07216878364870323f * L2E;
        const u16* qp = mlaq + qrow * 768 + hd * 192 + h * 8;
#pragma unroll
        for (int ks = 0; ks < 8; ++ks) { U4 v = *(const U4*)(qp + ks * 16); float tmp[8]; unpack8(v, tmp);
#pragma unroll
          for (int j = 0; j < 8; ++j) tmp[j] *= sc;
          q[ks] = __builtin_bit_cast(bf16x8, pack8(tmp)); }
        const bool lat = tq >= CTX;
        const int pos = tq - CTX; const float prow = (float)(pos >> 6), pcol = (float)(pos & 63);
#pragma unroll
        for (int ks = 8; ks < 10; ++ks) {
          U4 v1 = *(const U4*)(qp + ks * 16), v2 = *(const U4*)(qp + (ks + 2) * 16); float x1[8], x2[8]; unpack8(v1, x1); unpack8(v2, x2);
#pragma unroll
          for (int j = 0; j < 8; ++j) {
            int i = (ks - 8) * 16 + h * 8 + j; float inv = exp2f(-(float)(i & 15) * (1.f / 16.f) * L2_10000); float ang = (i < 16 ? prow : pcol) * inv;
            float sn = lat ? __sinf(ang) : 0.f, cs = lat ? __cosf(ang) : 1.f;
            float a = x1[j], c2 = x2[j]; x1[j] = (a * cs - c2 * sn) * sc; x2[j] = (c2 * cs + a * sn) * sc;
          }
          q[ks] = __builtin_bit_cast(bf16x8, pack8(x1)); q[ks + 2] = __builtin_bit_cast(bf16x8, pack8(x2));
        }
      }
      AttnState<192> st; for (int eb = 0; eb < 4; ++eb) st.ot[eb] = zero16(); st.m = -1e30f; st.l = 0.f;
      U4 rk[6], rv[4];
      const u16* kbase = mlakn + ((size_t)b * TT) * 512 + hd * 128; const unsigned koff0 = (unsigned)((tid >> 4) * 512 + (tid & 15) * 8);
      const u16* rbase = mlac + ((size_t)b * TT) * 704 + 640; const unsigned roff0 = (unsigned)((tid >> 3) * 704 + (tid & 7) * 8);
      const u16* vbase = mlavt + ((size_t)b * 512 + hd * 128) * TT; const unsigned voff0 = (unsigned)((tid >> 3) * TT + (tid & 7) * 8);
      auto gl = [&](int k0) {
#pragma unroll
        for (int i = 0; i < 4; ++i) rk[i] = *(const U4*)(kbase + (koff0 + (unsigned)((k0 + 16 * i) * 512)));
#pragma unroll
        for (int i = 0; i < 2; ++i) rk[4 + i] = *(const U4*)(rbase + (roff0 + (unsigned)((k0 + 32 * i) * 704)));
#pragma unroll
        for (int i = 0; i < 4; ++i) rv[i] = *(const U4*)(vbase + (voff0 + (unsigned)(32 * i * TT + k0)));
      };
      for (int k0 = 0; k0 < nk; k0 += 64) {
        gl(k0);
        __syncthreads();
#pragma unroll
        for (int i = 0; i < 4; ++i) { int c = tid + 256 * i, key = c >> 4, kc = c & 15; *(U4*)(Ks + key * KL + kc * 8) = rk[i]; }
#pragma unroll
        for (int i = 0; i < 2; ++i) { int c = tid + 256 * i, key = c >> 3, kc = c & 7; *(U4*)(Ks + key * KL + 128 + kc * 8) = rk[4 + i]; }
#pragma unroll
        for (int i = 0; i < 4; ++i) { int c = tid + 256 * i, e = c >> 3, kc = c & 7; *(U4*)(Vs + e * 72 + kc * 8) = rv[i]; }
        __syncthreads();
        attn_tile64<192, 12>(st, q, Ks, 0, Vs);
      }
      float lt = st.l + __shfl_xor(st.l, 32); float il = 1.f / lt;
#pragma unroll
      for (int eb = 0; eb < 4; ++eb)
#pragma unroll
        for (int g = 0; g < 4; ++g) {
          U2 v = mku2(pack2(st.ot[eb][4 * g] * il, st.ot[eb][4 * g + 1] * il), pack2(st.ot[eb][4 * g + 2] * il, st.ot[eb][4 * g + 3] * il));
          *(U2*)(omla + qrow * 512 + hd * 128 + eb * 32 + 8 * g + 4 * h) = v;
        }
    } else {
      const int it2 = item - n_mla;
      const int b = it2 / 528, rem = it2 % 528, qb = rem >> 2, hd = rem & 3;
      const int nk = qb < 4 ? CTX : TT;
      constexpr int KL = 136;
      u16* Ks = (u16*)ldsb; u16* Vs = Ks + 64 * KL;
      const int comp = w >> 1;
      const int tq = qb * 64 + (w & 1) * 32 + r; const size_t qrow = (size_t)b * TT + tq;
      bf16x8 q[4];
      {
        const float sc = 0.125f * L2E;
#pragma unroll
        for (int ks = 0; ks < 4; ++ks) { U4 v = *(const U4*)(daq + qrow * 512 + hd * 128 + comp * 64 + ks * 16 + h * 8); float tmp[8]; unpack8(v, tmp);
#pragma unroll
          for (int j = 0; j < 8; ++j) tmp[j] *= sc;
          q[ks] = __builtin_bit_cast(bf16x8, pack8(tmp)); }
      }
      AttnState<64> st; for (int eb = 0; eb < 4; ++eb) st.ot[eb] = zero16(); st.m = -1e30f; st.l = 0.f;
      U4 rk[4], rv[4];
      const u16* kbase = dak + ((size_t)b * TT) * 512 + hd * 128; const unsigned koff0 = (unsigned)((tid >> 4) * 512 + (tid & 15) * 8);
      const u16* vbase = davt + ((size_t)b * 512 + hd * 128) * TT; const unsigned voff0 = (unsigned)((tid >> 3) * TT + (tid & 7) * 8);
      auto gl = [&](int k0) {
#pragma unroll
        for (int i = 0; i < 4; ++i) rk[i] = *(const U4*)(kbase + (koff0 + (unsigned)((k0 + 16 * i) * 512)));
#pragma unroll
        for (int i = 0; i < 4; ++i) rv[i] = *(const U4*)(vbase + (voff0 + (unsigned)(32 * i * TT + k0)));
      };
      gl(0);
      for (int k0 = 0; k0 < nk; k0 += 64) {
        __syncthreads();
#pragma unroll
        for (int i = 0; i < 4; ++i) { int c = tid + 256 * i, key = c >> 4, kc = c & 15; *(U4*)(Ks + key * KL + kc * 8) = rk[i]; }
#pragma unroll
        for (int i = 0; i < 4; ++i) { int c = tid + 256 * i, e = c >> 3, kc = c & 7; *(U4*)(Vs + e * 72 + kc * 8) = rv[i]; }
        __syncthreads();
        if (k0 + 64 < nk) gl(k0 + 64);
        attn_tile64<64, 4>(st, q, Ks, comp * 64, Vs);
      }
      float lt = st.l + __shfl_xor(st.l, 32); float il = 1.f / lt;
      __syncthreads();
      float* O2 = (float*)ldsb;
      const int ql = (w & 1) * 32 + r;
      if (comp == 1) {
#pragma unroll
        for (int eb = 0; eb < 4; ++eb)
#pragma unroll
          for (int t = 0; t < 16; ++t) O2[ql * 132 + eb * 32 + crow(t, h)] = st.ot[eb][t] * il;
      }
      __syncthreads();
      if (comp == 0) {
        const float* lv = p->in[I_DALAM] + l * 256;
        float d1 = 0.f, d2 = 0.f;
#pragma unroll 4
        for (int i = 0; i < 64; ++i) { d1 += lv[i] * lv[64 + i]; d2 += lv[128 + i] * lv[192 + i]; }
        const float lam_init = 0.8f - 0.6f * expf(-0.3f * (float)l);
        const float lam = expf(d1) - expf(d2) + lam_init;
        float ss = 0.f;
#pragma unroll
        for (int eb = 0; eb < 4; ++eb)
#pragma unroll
          for (int t = 0; t < 16; ++t) { float o = st.ot[eb][t] * il - lam * O2[ql * 132 + eb * 32 + crow(t, h)]; st.ot[eb][t] = o; ss += o * o; }
        ss += __shfl_xor(ss, 32);
        const float rs = rsqrtf(ss * (1.f / 128.f) + EPS) * (1.f - lam_init);
        const float* sub = p->in[I_DASUB] + l * 128;
#pragma unroll
        for (int eb = 0; eb < 4; ++eb)
#pragma unroll
          for (int g = 0; g < 4; ++g) {
            int e = eb * 32 + 8 * g + 4 * h;
            U2 v = mku2(pack2(st.ot[eb][4 * g] * rs * sub[e], st.ot[eb][4 * g + 1] * rs * sub[e + 1]),
                                 pack2(st.ot[eb][4 * g + 2] * rs * sub[e + 2], st.ot[eb][4 * g + 3] * rs * sub[e + 3]));
            *(U2*)(daq + qrow * 512 + hd * 128 + e) = v;
          }
      }
    }
  }
}

constexpr int SL = 136;
DI void ssd_conv8(const u16* zx, int row, int lo, int hi, int ch0, const float* cw, const float* cb, float (&out)[8]) {
  F4 b0 = *(const F4*)(cb + ch0), b1 = *(const F4*)(cb + ch0 + 4);
  float acc[8] = {b0.x, b0.y, b0.z, b0.w, b1.x, b1.y, b1.z, b1.w};
#pragma unroll
  for (int k = 0; k < 5; ++k) {
    int rr = row + k - 2;
    if (rr >= lo && rr < hi) {
      U4 v = *(const U4*)(zx + (size_t)rr * 1536 + 512 + ch0); float x[8]; unpack8(v, x);
      F4 w0 = *(const F4*)(cw + k * 1024 + ch0), w1 = *(const F4*)(cw + k * 1024 + ch0 + 4);
      acc[0] += w0.x * x[0]; acc[1] += w0.y * x[1]; acc[2] += w0.z * x[2]; acc[3] += w0.w * x[3];
      acc[4] += w1.x * x[4]; acc[5] += w1.y * x[5]; acc[6] += w1.z * x[6]; acc[7] += w1.w * x[7];
    }
  }
#pragma unroll
  for (int e = 0; e < 8; ++e) out[e] = siluf(acc[e]);
}
DI float softplusf(float x) { return x > 20.f ? x : log1pf(__expf(x)); }
DI float wave_incl_scan(float v) {
  const int lane = get_tid() & 63;
  for (int o = 1; o < 64; o <<= 1) { float u = __shfl_up(v, o); if (lane >= o) v += u; }
  return v;
}

DI void phase_ssdconv(PP p, int l) {
  const u16* zx = (const u16*)(p->ws + A_SSDZX);
  u16* xs = (u16*)(p->ws + A_XSACT); u16* bc = (u16*)(p->ws + A_BCACT);
  const float* cw = p->in[I_SCW] + (size_t)l * 5 * 1024; const float* cb = p->in[I_SCB] + l * 1024;
  const int total = ROWS * 128;
  for (int i = get_bid() * 256 + get_tid(); i < total; i += gridDim.x * 256) {
    const int row = i >> 7, ch0 = (i & 127) * 8;
    const int b = row / TT, t = row - b * TT;
    const int lo = t < CTX ? b * TT : b * TT + CTX, hi = t < CTX ? b * TT + CTX : (b + 1) * TT;
    float v[8];
    ssd_conv8(zx, row, lo, hi, ch0, cw, cb, v);
    u16* dst = ch0 < 512 ? xs + (size_t)row * 512 + ch0 : bc + (size_t)row * 512 + (ch0 - 512);
    *(U4*)dst = pack8(v);
  }
}
DI void ssd_act8(const u16* base, int row, int col, float (&out)[8]) { U4 v = *(const U4*)(base + (size_t)row * 512 + col); unpack8(v, out); }

DI void phase_ssd1(PP p, int l, unsigned char* ldsb) {
  const int tid = get_tid(), lane = tid & 63, w = tid >> 6, r = lane & 31, h = lane >> 5;
  const u16* xsact = (const u16*)(p->ws + A_XSACT); const u16* bcact = (const u16*)(p->ws + A_BCACT); const float* dtraw = (const float*)(p->ws + S_DT);
  float* cdec = (float*)(p->ws + S_CDEC);
  const float* cw = p->in[I_SCW] + (size_t)l * 5 * 1024; const float* cb = p->in[I_SCB] + l * 1024;
  u16* BT = (u16*)ldsb; u16* xT = BT + 128 * SL; float* wts = (float*)(xT + 64 * SL);
  for (int item = get_bid(); item < NB * NCH * 8; item += gridDim.x) {
    const int b = item / (NCH * 8), rem = item % (NCH * 8), c = rem >> 3, head = rem & 7, g = head >> 2;
    const int rows0 = b * TT + c * 128;
    const int lo = c < 2 ? b * TT : b * TT + CTX, hi = c < 2 ? b * TT + CTX : (b + 1) * TT;
    __syncthreads();
    if (w < 2) {
      const int dir = w;
      const float bias = p->in[I_SDTB][l * 16 + dir * 8 + head]; const float Ah = -__expf(p->in[I_SALOG][l * 16 + dir * 8 + head]);
      float d0 = softplusf(dtraw[(size_t)(rows0 + 2 * lane) * 16 + dir * 8 + head] + bias);
      float d1 = softplusf(dtraw[(size_t)(rows0 + 2 * lane + 1) * 16 + dir * 8 + head] + bias);
      float a0 = d0 * Ah, a1 = d1 * Ah;
      float P1 = wave_incl_scan(a0 + a1), P0 = P1 - a1;
      float tot = __shfl(P1, 63);
      if (dir == 0) { wts[2 * lane] = d0 * __expf(tot - P0); wts[2 * lane + 1] = d1 * __expf(tot - P1); }
      else { wts[128 + 2 * lane] = d0 * __expf(P0 - a0); wts[128 + 2 * lane + 1] = d1 * __expf(P1 - a1); }
      if (lane == 0) cdec[((dir * NB + b) * NCH + c) * 8 + head] = __expf(tot);
    }
#pragma unroll
    for (int i = 0; i < 8; ++i) {
      int id = tid + 256 * i, lrow = id >> 4, ch = (id & 15) * 8; float v[8];
      ssd_act8(bcact, rows0 + lrow, g * 128 + ch, v);
#pragma unroll
      for (int e = 0; e < 8; ++e) BT[(ch + e) * SL + lrow] = f2bf(v[e]);
    }
    float xv[4][8];
#pragma unroll
    for (int i = 0; i < 4; ++i) { int id = tid + 256 * i, lrow = id >> 3, ch = (id & 7) * 8; ssd_act8(xsact, rows0 + lrow, head * 64 + ch, xv[i]); }
    for (int dir = 0; dir < 2; ++dir) {
      __syncthreads();
#pragma unroll
      for (int i = 0; i < 4; ++i) { int id = tid + 256 * i, lrow = id >> 3, ch = (id & 7) * 8; float wv = wts[dir * 128 + lrow];
#pragma unroll
        for (int e = 0; e < 8; ++e) xT[(ch + e) * SL + lrow] = f2bf(xv[i][e] * wv); }
      __syncthreads();
      f32x16 acc[2][1]; acc[0][0] = zero16(); acc[1][0] = zero16();
      wave_mma<2, 1>(acc, xT, SL, BT + (32 * w) * SL, SL, 128);
      u16* st = (u16*)(p->ws + (dir ? A_STB : A_STF)) + ((size_t)((b * NCH + c) * 8 + head)) * 64 * 128;
#pragma unroll
      for (int i = 0; i < 2; ++i)
#pragma unroll
        for (int t = 0; t < 16; ++t) st[(i * 32 + crow(t, h)) * 128 + 32 * w + r] = f2bf(acc[i][0][t]);
    }
  }
}

DI void phase_ssd2(PP p) {
  const float* cdec = (const float*)(p->ws + S_CDEC);
  const int total = NB * 8 * 64 * 128;
  for (int i = get_bid() * 256 + get_tid(); i < total; i += gridDim.x * 256) {
    int dir = i / (NB * 8 * 4096), rem = i % (NB * 8 * 4096), b = rem / (8 * 4096), rem2 = rem % (8 * 4096), head = rem2 / 4096, pn2 = rem2 % 4096;
    unsigned* S = (unsigned*)(p->ws + (dir ? A_STB : A_STF));
    float s0 = 0.f, s1 = 0.f;
#pragma unroll 1
    for (int k0 = 0; k0 < NCH; k0 += 6) {
      unsigned stv[6]; float dc[6]; unsigned idx[6];
#pragma unroll
      for (int u = 0; u < 6; ++u) {
        int k = k0 + u; int c = dir == 0 ? k : (k < 2 ? 1 - k : NCH + 1 - k);
        idx[u] = (unsigned)(((b * NCH + c) * 8 + head) * 4096 + pn2);
        stv[u] = S[idx[u]]; dc[u] = cdec[((dir * NB + b) * NCH + c) * 8 + head];
      }
#pragma unroll
      for (int u = 0; u < 6; ++u) { S[idx[u]] = pack2(s0, s1); s0 = s0 * dc[u] + lo2f(stv[u]); s1 = s1 * dc[u] + hi2f(stv[u]); }
    }
  }
}

DI void phase_ssd3(PP p, int l, bool need_ctx, unsigned char* ldsb) {
  const int tid = get_tid(), lane = tid & 63, w = tid >> 6, r = lane & 31, h = lane >> 5;
  const u16* xsact = (const u16*)(p->ws + A_XSACT); const u16* bcact = (const u16*)(p->ws + A_BCACT); const float* dtraw = (const float*)(p->ws + S_DT);
  const float* cw = p->in[I_SCW] + (size_t)l * 5 * 1024; const float* cb = p->in[I_SCB] + l * 1024;
  u16* Cs = (u16*)ldsb; u16* Bs = Cs + 128 * SL; float* cum = (float*)(Bs + 128 * SL);
  u16* ybuf = (u16*)(p->ws + A_YBUF);
  for (int item = get_bid(); item < NB * NCH * 8; item += gridDim.x) {
    const int b = item / (NCH * 8), rem = item % (NCH * 8), c = rem >> 3, head = rem & 7, g = head >> 2;
    if (c < 2 && !need_ctx) continue;
    const int rows0 = b * TT + c * 128;
    const int lo = c < 2 ? b * TT : b * TT + CTX, hi = c < 2 ? b * TT + CTX : (b + 1) * TT;
    __syncthreads();
    if (w < 2) {
      const int dir = w;
      const float bias = p->in[I_SDTB][l * 16 + dir * 8 + head]; const float Ah = -__expf(p->in[I_SALOG][l * 16 + dir * 8 + head]);
      float d0 = softplusf(dtraw[(size_t)(rows0 + 2 * lane) * 16 + dir * 8 + head] + bias);
      float d1 = softplusf(dtraw[(size_t)(rows0 + 2 * lane + 1) * 16 + dir * 8 + head] + bias);
      float a0 = d0 * Ah, a1 = d1 * Ah;
      float P1 = wave_incl_scan(a0 + a1), P0 = P1 - a1;
      if (dir == 0) { cum[2 * lane] = P0; cum[2 * lane + 1] = P1; cum[128 + 2 * lane] = d0; cum[128 + 2 * lane + 1] = d1; }
      else { cum[256 + 2 * lane] = P0 - a0; cum[256 + 2 * lane + 1] = P1 - a1; cum[384 + 2 * lane] = d0; cum[384 + 2 * lane + 1] = d1; if (lane == 63) cum[512] = P1; }
    }
#pragma unroll 2
    for (int i = 0; i < 8; ++i) {
      int id = tid + 256 * i, lrow = id >> 4, ch = (id & 15) * 8; float v[8];
      ssd_act8(bcact, rows0 + lrow, 256 + g * 128 + ch, v);
      *(U4*)(Cs + lrow * SL + ch) = pack8(v);
      ssd_act8(bcact, rows0 + lrow, g * 128 + ch, v);
      *(U4*)(Bs + lrow * SL + ch) = pack8(v);
    }
    __syncthreads();
    f32x16 G[1][4]; for (int j = 0; j < 4; ++j) G[0][j] = zero16();
    wave_mma<1, 4>(G, Cs + (32 * w) * SL, SL, Bs, SL, 128);
    __syncthreads();
    {
      const u16* sf = (const u16*)(p->ws + A_STF) + ((size_t)((b * NCH + c) * 8 + head)) * 8192;
      const u16* sb = (const u16*)(p->ws + A_STB) + ((size_t)((b * NCH + c) * 8 + head)) * 8192;
#pragma unroll 2
      for (int i = 0; i < 4; ++i) {
        int id = tid + 256 * i, pp = id >> 4, n8 = (id & 15) * 8;
        *(U4*)(Bs + pp * SL + n8) = *(const U4*)(sf + pp * 128 + n8);
        *(U4*)(Bs + (64 + pp) * SL + n8) = *(const U4*)(sb + pp * 128 + n8);
      }
    }
    __syncthreads();
    f32x16 af[1][2], ab[1][2]; af[0][0] = zero16(); af[0][1] = zero16(); ab[0][0] = zero16(); ab[0][1] = zero16();
    wave_mma<1, 2>(af, Cs + (32 * w) * SL, SL, Bs, SL, 128);
    wave_mma<1, 2>(ab, Cs + (32 * w) * SL, SL, Bs + 64 * SL, SL, 128);
    f32x16 ad[1][2];
    { const float PbTot = cum[512];
#pragma unroll
      for (int j = 0; j < 2; ++j)
#pragma unroll
        for (int t = 0; t < 16; ++t) { const int lr = 32 * w + crow(t, h); ad[0][j][t] = __expf(cum[lr]) * af[0][j][t] + __expf(PbTot - cum[256 + lr]) * ab[0][j][t]; } }
    __syncthreads();
    {
#pragma unroll
      for (int j = 0; j < 4; ++j) {
        const int s = 32 * j + r; const float Pfs = cum[s], dtfs = cum[128 + s], Ebs = cum[256 + s], dtbs = cum[384 + s];
#pragma unroll
        for (int t = 0; t < 16; ++t) {
          const int lr = 32 * w + crow(t, h);
          float mf = (s <= lr) ? __expf(fminf(cum[lr] - Pfs, 0.f)) * dtfs : 0.f;
          float mb = (s >= lr) ? __expf(fminf(Ebs - cum[256 + lr], 0.f)) * dtbs : 0.f;
          Bs[lr * SL + s] = f2bf(G[0][j][t] * (mf + mb));
        }
      }
#pragma unroll 2
      for (int i = 0; i < 4; ++i) { int id = tid + 256 * i, lrow = id >> 3, ch = (id & 7) * 8; float v[8];
        ssd_act8(xsact, rows0 + lrow, head * 64 + ch, v);
#pragma unroll
        for (int e = 0; e < 8; ++e) Cs[(ch + e) * SL + lrow] = f2bf(v[e]); }
    }
    __syncthreads();
    wave_mma<1, 2>(ad, Bs + (32 * w) * SL, SL, Cs, SL, 128);
    const float Dh = p->in[I_SD][l * 8 + head];
#pragma unroll
    for (int j = 0; j < 2; ++j)
#pragma unroll
      for (int t = 0; t < 16; ++t) {
        const int lr = 32 * w + crow(t, h), pp = 32 * j + r;
        float y = ad[0][j][t] + Dh * bf2f(Cs[pp * SL + lr]);
        ybuf[(size_t)(rows0 + lr) * 512 + head * 64 + pp] = f2bf(y);
      }
  }
}

DI void phase_ssd4(PP p, int l, bool need_ctx) {
  const int lane = get_tid() & 63, w = get_tid() >> 6;
  u16* zx = (u16*)(p->ws + A_SSDZX); const u16* ybuf = (const u16*)(p->ws + A_YBUF); const float* gn = p->in[I_SNORM] + l * 512;
  for (int r = get_bid() * 4 + w; r < ROWS; r += gridDim.x * 4) {
    int t = r % TT; if (t < CTX && !need_ctx) continue;
    U4 yv = *(const U4*)(ybuf + (size_t)r * 512 + lane * 8), zv = *(const U4*)(zx + (size_t)r * 1536 + lane * 8);
    float y[8], z[8]; unpack8(yv, y); unpack8(zv, z);
    float ss = 0.f;
#pragma unroll
    for (int e = 0; e < 8; ++e) { y[e] *= siluf(z[e]); ss += y[e] * y[e]; }
    ss = wave_sum(ss); float rstd = rsqrtf(ss * (1.f / 512.f) + EPS);
#pragma unroll
    for (int e = 0; e < 8; ++e) y[e] *= rstd * gn[lane * 8 + e];
    *(U4*)(zx + (size_t)r * 1536 + lane * 8) = pack8(y);
  }
}

DI F2 cmul(F2 a, F2 b) { return mkf2(a.x * b.x - a.y * b.y, a.x * b.y + a.y * b.x); }
DI F2 cmulc(F2 a, F2 b) { return mkf2(a.x * b.x + a.y * b.y, a.y * b.x - a.x * b.y); }
#define LP(i) ((i) + ((i) >> 5))
DI F2 twid2(int j) { const float r = (float)j * (1.f / 16384.f); return mkf2(__builtin_amdgcn_cosf(r), -__builtin_amdgcn_sinf(r)); }
DI F2 twid(int k) { const float r = (float)k * (1.f / 8192.f); return mkf2(__builtin_amdgcn_cosf(r), -__builtin_amdgcn_sinf(r)); }
DI void fft_fwd(F2* L) {
  const int tid = get_tid();
#pragma unroll 1
  for (int s = 0; s < 12; s += 2) {
    const int hB = 2048 >> s, lg = 11 - s;
#pragma unroll 8
    for (int g = tid; g < 2048; g += 256) {
      const int pos = g & (hB - 1), grp = g >> lg;
      const int i0 = (grp << (lg + 2)) + pos;
      F2 x0 = L[LP(i0)], x1 = L[LP(i0 + hB)], x2 = L[LP(i0 + 2 * hB)], x3 = L[LP(i0 + 3 * hB)];
      const F2 wA = twid(pos << s); const F2 wA2 = mkf2(wA.y, -wA.x); const F2 wB = cmul(wA, wA);
      F2 a0 = mkf2(x0.x + x2.x, x0.y + x2.y), a2 = cmul(mkf2(x0.x - x2.x, x0.y - x2.y), wA);
      F2 a1 = mkf2(x1.x + x3.x, x1.y + x3.y), a3 = cmul(mkf2(x1.x - x3.x, x1.y - x3.y), wA2);
      L[LP(i0)] = mkf2(a0.x + a1.x, a0.y + a1.y); L[LP(i0 + hB)] = cmul(mkf2(a0.x - a1.x, a0.y - a1.y), wB);
      L[LP(i0 + 2 * hB)] = mkf2(a2.x + a3.x, a2.y + a3.y); L[LP(i0 + 3 * hB)] = cmul(mkf2(a2.x - a3.x, a2.y - a3.y), wB);
    }
    __syncthreads();
  }
#pragma unroll 8
  for (int q = tid; q < 4096; q += 256) { F2 u = L[LP(2 * q)], v = L[LP(2 * q + 1)]; L[LP(2 * q)] = mkf2(u.x + v.x, u.y + v.y); L[LP(2 * q + 1)] = mkf2(u.x - v.x, u.y - v.y); }
  __syncthreads();
}
DI void fft_inv(F2* L) {
  const int tid = get_tid();
#pragma unroll 8
  for (int q = tid; q < 4096; q += 256) { F2 u = L[LP(2 * q)], v = L[LP(2 * q + 1)]; L[LP(2 * q)] = mkf2(u.x + v.x, u.y + v.y); L[LP(2 * q + 1)] = mkf2(u.x - v.x, u.y - v.y); }
  __syncthreads();
#pragma unroll 1
  for (int s = 10; s >= 0; s -= 2) {
    const int hB = 2048 >> s, lg = 11 - s;
#pragma unroll 8
    for (int g = tid; g < 2048; g += 256) {
      const int pos = g & (hB - 1), grp = g >> lg;
      const int i0 = (grp << (lg + 2)) + pos;
      F2 y0 = L[LP(i0)], y1 = L[LP(i0 + hB)], y2 = L[LP(i0 + 2 * hB)], y3 = L[LP(i0 + 3 * hB)];
      const F2 wA = twid(pos << s); const F2 wA2 = mkf2(wA.y, -wA.x); const F2 wB = cmul(wA, wA);
      F2 v1 = cmulc(y1, wB), v3 = cmulc(y3, wB);
      F2 a0 = mkf2(y0.x + v1.x, y0.y + v1.y), a1 = mkf2(y0.x - v1.x, y0.y - v1.y);
      F2 a2 = mkf2(y2.x + v3.x, y2.y + v3.y), a3 = mkf2(y2.x - v3.x, y2.y - v3.y);
      F2 u2 = cmulc(a2, wA), u3 = cmulc(a3, wA2);
      L[LP(i0)] = mkf2(a0.x + u2.x, a0.y + u2.y); L[LP(i0 + 2 * hB)] = mkf2(a0.x - u2.x, a0.y - u2.y);
      L[LP(i0 + hB)] = mkf2(a1.x + u3.x, a1.y + u3.y); L[LP(i0 + 3 * hB)] = mkf2(a1.x - u3.x, a1.y - u3.y);
    }
    __syncthreads();
  }
}
DI float hy_delta(int c) {
  const float a = -4.605170185988091f / 1.5f, bq = -4.605170185988091f / 0.3f;
  return fabsf(a + (bq - a) * ((float)c / 511.f));
}
DI float block_sum(float v, float* red  ) {
  v = wave_sum(v);
  __syncthreads();
  if ((get_tid() & 63) == 0) red[get_tid() >> 6] = v;
  __syncthreads();
  return red[0] + red[1] + red[2] + red[3];
}

DI void phase_hyspec(PP p, int l, TileIter& it, unsigned char* ldsb) {
  const int tid = get_tid();
  F2* L = (F2*)ldsb; float* misc = (float*)(ldsb + 67584);
  float* tmpF = (float*)ldsb; float* tmpB = tmpF + FN;
  const F2* W2 = (const F2*)(p->ws + S_W2); const u16* hid = (const u16*)(p->ws + S_HID);
  const float* w3 = p->in[I_HW3] + (size_t)l * 64 * 2048;
  F2* Gs = (F2*)(p->ws + A_GSPEC);
  FOR_TILES(it, 1024, item) {
    const int o = item >> 9, c = item & 511;
    __syncthreads();
    if (tid < 64) misc[tid] = w3[tid * 2048 + o * 512 + c]; else if (tid < 128) misc[tid] = w3[(tid - 64) * 2048 + 1024 + o * 512 + c];
    __syncthreads();
    const float delta = hy_delta(c);
    float ss = 0.f;
#pragma unroll 1
    for (int i = 0; i < 32; ++i) {
      const int t = tid + 256 * i; const u16* hr = hid + (size_t)t * 64;
      float df = 0.f, db = 0.f;
#pragma unroll
      for (int k8 = 0; k8 < 8; ++k8) { U4 hq = *(const U4*)(hr + k8 * 8); float hv[8]; unpack8(hq, hv);
#pragma unroll
        for (int e = 0; e < 8; ++e) { df += hv[e] * misc[k8 * 8 + e]; db += hv[e] * misc[64 + k8 * 8 + e]; } }
      const float dec = __expf(-((float)t / 8191.f) * delta);
      df *= dec; db *= dec; tmpF[t] = df; tmpB[t] = db;
      ss += (t == 0) ? (df + db) * (df + db) : (df * df + db * db);
    }
    ss = block_sum(ss, misc + 128);
    const float scale = rsqrtf(ss + EPS) * (1.f / 16384.f);
    F2* zs = (F2*)(p->ws + A_ZSAVE) + (size_t)get_bid() * FN;
#pragma unroll 8
    for (int i = 0; i < 32; ++i) { int j = tid + 256 * i; zs[j] = mkf2(tmpF[j] * scale, tmpB[j == 0 ? 0 : FN - j] * scale); }
    __syncthreads();
#pragma unroll 8
    for (int i = 0; i < 32; ++i) { int j = tid + 256 * i; F2 v = zs[j]; L[LP(j)] = mkf2(v.x + v.y, 0.f); }
    __syncthreads();
    fft_fwd(L);
    F2* dst = Gs + (size_t)item * 2 * FN;
#pragma unroll 8
    for (int i = 0; i < 32; ++i) dst[tid + 256 * i] = L[LP(tid + 256 * i)];
    __syncthreads();
#pragma unroll 8
    for (int i = 0; i < 32; ++i) { int j = tid + 256 * i; F2 v = zs[j]; float gv = (j == 0 ? v.x + v.y : v.x - v.y); F2 wv = twid2(j); L[LP(j)] = mkf2(gv * wv.x, gv * wv.y); }
    __syncthreads();
    fft_fwd(L);
#pragma unroll 8
    for (int i = 0; i < 32; ++i) dst[FN + tid + 256 * i] = L[LP(tid + 256 * i)];
  }
  it.off += 1024;
}

DI float hy_u_lat_sh(const u16* PT, int b, int col, int j, float w0, float w1, float w2, float bias) {
  const u16* rowp = PT + ((size_t)b * 1536 + col) * TT + CTX;
  const int lane = get_tid() & 63;
  const float c = bf2f(rowp[j]);
  float lft = __shfl_up(c, 1), rgt = __shfl_down(c, 1);
  if (lane == 0) lft = (j > 0) ? bf2f(rowp[j - 1]) : 0.f;
  if (lane == 63) rgt = (j < SEQ - 1) ? bf2f(rowp[j + 1]) : 0.f;
  return bias + w1 * c + w0 * lft + w2 * rgt;
}
DI float hy_u_lat(const u16* PT, int b, int col, int j, float w0, float w1, float w2, float bias) {
  const u16* rowp = PT + ((size_t)b * 1536 + col) * TT + CTX;
  float v = bias + w1 * bf2f(rowp[j]);
  if (j > 0) v += w0 * bf2f(rowp[j - 1]);
  if (j < SEQ - 1) v += w2 * bf2f(rowp[j + 1]);
  return v;
}
DI float hy_u_ctx(const u16* PT, int b, int col, int j, float w0, float w1, float w2, float bias) {
  const u16* rowp = PT + ((size_t)b * 1536 + col) * TT;
  float v = bias + w1 * bf2f(rowp[j]);
  if (j > 0) v += w0 * bf2f(rowp[j - 1]);
  if (j < CTX - 1) v += w2 * bf2f(rowp[j + 1]);
  return v;
}

DI void phase_hyconv(PP p, int l, bool need_ctx, unsigned char* ldsb) {
  const int tid = get_tid();
  F2* L = (F2*)ldsb; float* misc = (float*)(ldsb + 67584);
  const F2* W2 = (const F2*)(p->ws + S_W2);
  const u16* PT = (const u16*)(p->ws + A_PTHY); const F2* Gs = (const F2*)(p->ws + A_GSPEC);
  u16* ohy = (u16*)(p->ws + A_OHY);
  const float* cw = p->in[I_HCW] + (size_t)l * 3 * 1536; const float* cb = p->in[I_HCB] + l * 1536; const float* hb = p->in[I_HBIAS] + l * 1024;
  const int nlat = 1024, nctx = need_ctx ? 512 : 0;
  for (int item = get_bid(); item < nlat + nctx; item += gridDim.x) {
    __syncthreads();
    if (item < nlat) {
      const int bp = item >> 9, c = item & 511, b0 = 2 * bp, b1 = b0 + 1;
      unsigned* zs = (unsigned*)(p->ws + A_ZSAVE) + (size_t)get_bid() * FN;
      unsigned* ys = (unsigned*)(p->ws + A_YSAVE) + (size_t)get_bid() * FN;
      { const float w0 = cw[c], w1 = cw[1536 + c], w2 = cw[3072 + c], bi = cb[c];
#pragma unroll 4
        for (int i = 0; i < 32; ++i) { int j = tid + 256 * i; F2 z = mkf2(hy_u_lat(PT, b0, c, j, w0, w1, w2, bi), hy_u_lat(PT, b1, c, j, w0, w1, w2, bi)); const unsigned zp = pack2(z.x, z.y); zs[j] = zp; L[LP(j)] = mkf2(lo2f(zp), hi2f(zp)); } }
      __syncthreads();
#pragma unroll 1
      for (int o = 0; o < 2; ++o) {
        const F2* Ge = Gs + ((size_t)(o * 512 + c) * 2) * FN; const F2* Go = Ge + FN;
        fft_fwd(L);
#pragma unroll 16
        for (int i = 0; i < 32; ++i) { int k = tid + 256 * i; L[LP(k)] = cmul(L[LP(k)], Ge[k]); }
        __syncthreads();
        fft_inv(L);
#pragma unroll 8
        for (int i = 0; i < 32; ++i) { int j = tid + 256 * i; F2 yv = L[LP(j)]; ys[j] = pack2(yv.x, yv.y); }
        __syncthreads();
#pragma unroll 8
        for (int i = 0; i < 32; ++i) { int j = tid + 256 * i; unsigned zp = zs[j]; L[LP(j)] = cmul(mkf2(lo2f(zp), hi2f(zp)), twid2(j)); }
        __syncthreads();
        fft_fwd(L);
#pragma unroll 16
        for (int i = 0; i < 32; ++i) { int k = tid + 256 * i; L[LP(k)] = cmul(L[LP(k)], Go[k]); }
        __syncthreads();
        fft_inv(L);
        const int col = (1 + o) * 512 + c;
        const float w0 = cw[col], w1 = cw[1536 + col], w2 = cw[3072 + col], bi = cb[col], hbias = hb[o * 512 + c];
#pragma unroll 4
        for (int i = 0; i < 32; ++i) { int j = tid + 256 * i; F2 yo = cmulc(L[LP(j)], twid2(j)); unsigned yp = ys[j], zp = zs[j]; F2 ye = mkf2(lo2f(yp), hi2f(yp)); F2 z = mkf2(lo2f(zp), hi2f(zp));
          float yr = ye.x + yo.x, yi = ye.y + yo.y;
          float zr = hy_u_lat(PT, b0, col, j, w0, w1, w2, bi) * (yr + hbias * z.x);
          float zi = hy_u_lat(PT, b1, col, j, w0, w1, w2, bi) * (yi + hbias * z.y);
          if (o == 0) { const unsigned zq = pack2(zr, zi); zs[j] = zq; L[LP(j)] = mkf2(lo2f(zq), hi2f(zq)); }
          else { ohy[((size_t)b0 * TT + CTX + j) * 512 + c] = f2bf(zr); ohy[((size_t)b1 * TT + CTX + j) * 512 + c] = f2bf(zi); } }
        __syncthreads();
      }
    } else {
      const int c = item - nlat, t = tid;
      float* g = (float*)ldsb;
      float* zs = g + 1024;
      float* wv = zs + 256;
      float* red = wv + 256;
      const float* hidc = (const float*)(p->ws + S_HIDC); const float* w3 = p->in[I_HW3] + (size_t)l * 64 * 2048;
      { int which = tid >> 6, k = tid & 63; int dir = which >> 1, o = which & 1; wv[tid] = w3[k * 2048 + dir * 1024 + o * 512 + c]; }
      __syncthreads();
      const float dec = __expf(-((float)t / 255.f) * hy_delta(c));
      float f[2], bk[2];
      { float d[4] = {0.f, 0.f, 0.f, 0.f};
#pragma unroll 4
        for (int k = 0; k < 64; ++k) { float hv = hidc[t * 64 + k]; d[0] += hv * wv[k]; d[1] += hv * wv[64 + k]; d[2] += hv * wv[128 + k]; d[3] += hv * wv[192 + k]; }
        f[0] = d[0] * dec; f[1] = d[1] * dec; bk[0] = d[2] * dec; bk[1] = d[3] * dec; }
      for (int o = 0; o < 2; ++o) {
        float ss = (t == 0) ? (f[o] + bk[o]) * (f[o] + bk[o]) : (f[o] * f[o] + bk[o] * bk[o]);
        ss = block_sum(ss, red);
        float sc = rsqrtf(ss + EPS);
        if (t == 0) { g[o * 512] = (f[o] + bk[o]) * sc; g[o * 512 + 256] = 0.f; }
        else { g[o * 512 + t] = f[o] * sc; g[o * 512 + 512 - t] = bk[o] * sc; }
      }
      __syncthreads();
#pragma unroll 1
      for (int b = 0; b < NB; ++b) {
        float z = hy_u_ctx(PT, b, c, t, cw[c], cw[1536 + c], cw[3072 + c], cb[c]);
        for (int o = 0; o < 2; ++o) {
          __syncthreads();
          zs[t] = z;
          __syncthreads();
          float y = 0.f;
#pragma unroll 4
          for (int s = 0; s < 256; ++s) y += zs[s] * g[o * 512 + ((t - s) & 511)];
          const int col = (1 + o) * 512 + c;
          z = hy_u_ctx(PT, b, col, t, cw[col], cw[1536 + col], cw[3072 + col], cb[col]) * (y + hb[o * 512 + c] * z);
        }
        ohy[((size_t)b * TT + t) * 512 + c] = f2bf(z);
      }
    }
  }
}

DI void phase_merge(PP p, u16* lds, bool skipc) {
  unsigned char* ws = p->ws;
  const u16* H = (const u16*)(ws + H_OFF); const u16* Wg = (const u16*)(ws + W_WIN) + (size_t)OFF_GATE * DM; const u16* Wbr = (const u16*)(ws + W_BR);
  u16* mixed = (u16*)(ws + A_MIXED);
  const int ntile = (skipc ? NB * 64 : ROWS / 128) * 8;
  for (int ti = get_bid(); ti < ntile; ti += gridDim.x) {
    int tm = ti >> 3, tn = ti & 7;
    if (skipc) tm = NCH * (tm >> 6) + 2 + (tm & 63);
    unsigned amp[2][2][8];
#pragma unroll
    for (int a = 0; a < 2; ++a)
#pragma unroll
      for (int bq = 0; bq < 2; ++bq)
#pragma unroll
        for (int t = 0; t < 8; ++t) amp[a][bq][t] = 0u;
#pragma unroll 1
    for (int i = 0; i < 4; ++i) {
      unsigned gp[2][2][8];
      {
        f32x16 ag[2][2]; zero_acc<2>(ag);
        gemm_acc<2>(ag, H + (size_t)tm * 128 * DM, DM, Wg + ((size_t)i * 1024 + tn * 128) * DM, DM, DM, lds);
#pragma unroll
        for (int a = 0; a < 2; ++a)
#pragma unroll
          for (int bq = 0; bq < 2; ++bq)
#pragma unroll
            for (int t = 0; t < 8; ++t) gp[a][bq][t] = pack2(sigmoidf(ag[a][bq][2 * t]), sigmoidf(ag[a][bq][2 * t + 1]));
      }
      f32x16 ao[2][2]; zero_acc<2>(ao);
      const u16* Oi = (const u16*)(ws + (i == 0 ? A_DAQ : i == 1 ? A_SSDZX : i == 2 ? A_OMLA : A_OHY)); const int ldi = (i == 1) ? 1536 : 512;
      gemm_acc<2>(ao, Oi + (size_t)tm * 128 * ldi, ldi, Wbr + ((size_t)i * 1024 + tn * 128) * 512, 512, 512, lds);
#pragma unroll
      for (int a = 0; a < 2; ++a)
#pragma unroll
        for (int bq = 0; bq < 2; ++bq)
#pragma unroll
          for (int t = 0; t < 8; ++t) amp[a][bq][t] = pack2(lo2f(amp[a][bq][t]) + lo2f(gp[a][bq][t]) * ao[a][bq][2 * t], hi2f(amp[a][bq][t]) + hi2f(gp[a][bq][t]) * ao[a][bq][2 * t + 1]);
    }
    f32x16 am[2][2];
#pragma unroll
    for (int a = 0; a < 2; ++a)
#pragma unroll
      for (int bq = 0; bq < 2; ++bq)
#pragma unroll
        for (int t = 0; t < 8; ++t) { am[a][bq][2 * t] = lo2f(amp[a][bq][t]); am[a][bq][2 * t + 1] = hi2f(amp[a][bq][t]); }
    store_tile_bf16<2>(am, mixed, DM, tm * 128, tn * 128, DM);
  }
}

DI void phase_ffn1(PP p, u16* lds, bool skipc) {
  unsigned char* ws = p->ws;
  const u16* H = (const u16*)(ws + H_OFF); const u16* W1 = (const u16*)(ws + W_F1); const u16* W3 = (const u16*)(ws + W_F3);
  u16* act = (u16*)(ws + A_ACT);
  const int ntn = FFN / 128, ntile = (skipc ? NB * 64 : ROWS / 128) * ntn;
  for (int ti = get_bid(); ti < ntile; ti += gridDim.x) {
    int tm = ti / ntn, tn = ti % ntn;
    if (skipc) tm = NCH * (tm >> 6) + 2 + (tm & 63);
    f32x16 a1[2][2], a3[2][2]; zero_acc<2>(a1); zero_acc<2>(a3);
    gemm_acc<2>(a1, H + (size_t)tm * 128 * DM, DM, W1 + (size_t)tn * 128 * DM, DM, DM, lds);
    gemm_acc<2>(a3, H + (size_t)tm * 128 * DM, DM, W3 + (size_t)tn * 128 * DM, DM, DM, lds);
#pragma unroll
    for (int a = 0; a < 2; ++a)
#pragma unroll
      for (int bq = 0; bq < 2; ++bq)
#pragma unroll
        for (int t = 0; t < 16; ++t) a1[a][bq][t] = siluf(a1[a][bq][t]) * a3[a][bq][t];
    store_tile_bf16<2>(a1, act, FFN, tm * 128, tn * 128, FFN);
  }
}

DI void phase_gemm_mla(PP p, u16* lds) {
  unsigned char* ws = p->ws;
  const u16* mc = (const u16*)(ws + A_MLAC);
  TileIter it{0};
  gemm_job(it, mc, 704, (const u16*)(ws + W_UQ), 384, 384, 768, 0, ws + A_MLAQ, 768, lds);
  const u16* Wkv = (const u16*)(ws + W_UKV);
  const int ntile = (ROWS / 128) * 8;
  FOR_TILES(it, ntile, ti) {
    int tm = ti >> 3, tn = ti & 7, hd = tn >> 1;
    f32x16 acc[2][2]; zero_acc<2>(acc);
    if ((tn & 1) == 0) {
      gemm_acc<2, true>(acc, mc + (size_t)tm * 128 * 704 + 384, 704, Wkv + (size_t)tn * 128 * 256, 256, 256, lds);
      store_tile_bf16<2>(acc, (u16*)(ws + A_MLAKN), 512, tm * 128, hd * 128, 512);
    } else {
      gemm_acc<2, false>(acc, mc + (size_t)tm * 128 * 704 + 384, 704, Wkv + (size_t)tn * 128 * 256, 256, 256, lds);
      store_tile_T(acc, (u16*)(ws + A_MLAVT), 512, tm * 128, hd * 128);
    }
  }
}


#define XB_TMO      128
#define XB_XCNT(j)  (256  + 64 * (j))
#define XB_XSUB(j)  (1280 + 64 * (j))
#define XB_XGEN(j)  (2304 + 64 * (j))
#define XB_TOP      3328
#define XB_TOPGEN   3392
#define XCD_BAR_WORDS 3456
#define XB_SPIN_CAP (1u << 20)
#define LAS __attribute__((address_space(3)))
DI unsigned xb_ld(unsigned* p)              { return __hip_atomic_load(p, __ATOMIC_RELAXED, __HIP_MEMORY_SCOPE_AGENT); }
DI unsigned xb_add(unsigned* p, unsigned v) { return __hip_atomic_fetch_add(p, v, __ATOMIC_RELAXED, __HIP_MEMORY_SCOPE_AGENT); }
DI unsigned xb_xcc_id() { return (unsigned)__builtin_amdgcn_s_getreg((3 << 11) | 20) & 0xFu; }
#define XB_SPIN(cond, bar) do { unsigned _sp = 0; while (cond) { __builtin_amdgcn_s_sleep(1); \
    if ((++_sp & 255u) == 0u) { if (xb_ld(&(bar)[XB_TMO])) break; if (_sp > XB_SPIN_CAP) { atomicAdd(&(bar)[XB_TMO], 1u); break; } } } } while (0)
struct XcdBarrier { unsigned* bar; unsigned x; volatile LAS unsigned* st; };
DI XcdBarrier xcd_barrier_post(unsigned* bar, volatile LAS unsigned* st) {
  XcdBarrier b; b.bar = bar; b.x = xb_xcc_id(); b.st = st;
  if (threadIdx.x == 0) (void)xb_add(&bar[XB_XCNT(b.x)], 1u);
  return b;
}
DI void xcd_barrier_complete(unsigned* bar, unsigned x, unsigned& nloc, unsigned& nx) {
  const unsigned G = gridDim.x * gridDim.y * gridDim.z;
  unsigned sum, cnt, mine, sp = 0u;
  for (;;) {
    sum = 0u; cnt = 0u; mine = 0u;
#pragma unroll
    for (unsigned j = 0; j < 16; ++j) { const unsigned c = xb_ld(&bar[XB_XCNT(j)]); sum += c; cnt += (c > 0u) ? 1u : 0u; mine = (j == x) ? c : mine; }
    if (sum == G) break;
    __builtin_amdgcn_s_sleep(1);
    if ((++sp & 255u) == 0u) { if (xb_ld(&bar[XB_TMO])) break; if (sp > XB_SPIN_CAP) { atomicAdd(&bar[XB_TMO], 1u); break; } }
  }
  nloc = mine > 0u ? mine : 1u; nx = cnt > 0u ? cnt : 1u;
}
DI void xcd_barrier(const XcdBarrier& b) {
  asm volatile("s_waitcnt vmcnt(0)" ::: "memory");
  __syncthreads();
  if (threadIdx.x == 0) {
    unsigned* bar = b.bar;
    __builtin_amdgcn_s_waitcnt(0);
    unsigned nloc = b.st[0], nx = b.st[1];
    if (nloc == 0u) { xcd_barrier_complete(bar, b.x, nloc, nx); b.st[0] = nloc; b.st[1] = nx; }
    const unsigned old = xb_add(&bar[XB_XSUB(b.x)], 1u);
    const unsigned gen = old / nloc;
    if (old + 1u == (gen + 1u) * nloc) {
      __builtin_amdgcn_fence(__ATOMIC_RELEASE, "agent");
      asm volatile("s_waitcnt vmcnt(0)" ::: "memory");
      const unsigned og = xb_add(&bar[XB_TOP], 1u);
      const unsigned tg = og / nx;
      if (og + 1u == (tg + 1u) * nx) xb_add(&bar[XB_TOPGEN], 1u);
      else XB_SPIN(xb_ld(&bar[XB_TOPGEN]) == tg, bar);
      __builtin_amdgcn_fence(__ATOMIC_ACQUIRE, "agent");
      xb_add(&bar[XB_XGEN(b.x)], 1u);
      asm volatile("s_waitcnt vmcnt(0)" ::: "memory");
    } else {
      XB_SPIN(xb_ld(&bar[XB_XGEN(b.x)]) == gen, bar);
      __builtin_amdgcn_fence(__ATOMIC_ACQUIRE, "agent");
      asm volatile("s_waitcnt vmcnt(0)" ::: "memory");
    }
  }
  __syncthreads();
}

constexpr int NPH = 21;
__host__ __device__ inline bool phase_empty(int ph) { int l = ph / NPH, k = ph % NPH; return l == 1 && (k == 1 || k == 2); }

DI void run_phase(PP p, int ph, unsigned char* lds) {
  const int l = ph / NPH, k = ph % NPH;
  const bool last = (l == 1), need_ctx = !last;
  unsigned char* ws = p->ws;
  const u16* H = (const u16*)(ws + H_OFF);
  const u16* Win = (const u16*)(ws + W_WIN);
#ifdef ONLY_PHASE
  if (k != ONLY_PHASE) return;
#endif
  switch (k) {
    case 0: phase_conv(p, l, lds); break;
    case 1: phase_modfin(p); break;
    case 2: phase_rowwise(p, true, nullptr, nullptr, 0, 0, true, p->in[I_NMPRE], 0, 0, 1, false); break;
    case 3: { TileIter it{0};
      gemm_job(it, H, DM, Win + (size_t)OFF_HY * DM, DM, DM, 1536, 2, ws + A_PTHY, 0, (u16*)lds, last);
      phase_hyspec(p, l, it, lds); } break;
    case 4: phase_hyconv(p, l, need_ctx, lds); break;
    case 5: { TileIter it{0};
      gemm_job(it, H, DM, Win + (size_t)(OFF_DA + 0) * DM, DM, DM, 512, 0, ws + A_DAQ, 512, (u16*)lds);
      gemm_job(it, H, DM, Win + (size_t)(OFF_DA + 512) * DM, DM, DM, 512, 0, ws + A_DAK, 512, (u16*)lds);
      gemm_job(it, H, DM, Win + (size_t)(OFF_DA + 1024) * DM, DM, DM, 512, 2, ws + A_DAVT, 0, (u16*)lds);
      gemm_job(it, H, DM, Win + (size_t)OFF_MLA * DM, DM, DM, 704, 0, ws + A_MLAC, 704, (u16*)lds); } break;
    case 6: phase_rope(p, l); break;
    case 7: phase_gemm_mla(p, (u16*)lds); break;
    case 8: phase_attn(p, l, need_ctx, lds);
#ifdef PROBE_MLA
      phase_attn(p, l, need_ctx, lds, 1);
#endif
      break;
    case 9: { TileIter it{0};
      gemm_job(it, H, DM, Win + (size_t)OFF_SSD * DM, DM, DM, 1536, 0, ws + A_SSDZX, 1536, (u16*)lds);
      gemm_job(it, H, DM, Win + (size_t)(OFF_SSD + 1536) * DM, DM, DM, 16, 1, ws + S_DT, 16, (u16*)lds); } break;
    case 10: phase_ssdconv(p, l); break;
    case 11: phase_ssd1(p, l, lds); break;
    case 12: phase_ssd2(p); break;
    case 13: phase_ssd3(p, l, need_ctx, lds); break;
    case 14: phase_ssd4(p, l, need_ctx); break;
    case 15: phase_merge(p, (u16*)lds, last); break;
    case 16: { TileIter it{0}; gemm_job(it, (const u16*)(ws + A_MIXED), DM, (const u16*)(ws + W_OUT), DM, DM, DM, 0, ws + A_YOUT, DM, (u16*)lds, last); } break;
    case 17: phase_rowwise(p, l == 0, (const u16*)(ws + A_YOUT), p->in[I_NMPOST] + l * DM, l, 2, true, p->in[I_NFPRE] + l * DM, l, 3, 4, last); break;
    case 18: phase_ffn1(p, (u16*)lds, last); break;
    case 19: { TileIter it{0}; gemm_job(it, (const u16*)(ws + A_ACT), FFN, (const u16*)(ws + W_F2), FFN, FFN, DM, 0, ws + A_F, DM, (u16*)lds, last); } break;
    case 20: phase_rowwise(p, false, (const u16*)(ws + A_F), p->in[I_NFPOST] + l * DM, l, 5, !last, p->in[I_NMPRE] + (last ? 0 : (l + 1) * DM), last ? l : l + 1, 0, 1, last); break;
  }
}

__global__ void __launch_bounds__(256, 2) mega_kernel(Params p_unused, int ph_lo, int ph_hi) {
  extern __shared__ __attribute__((aligned(16))) unsigned char lds[];
  __shared__ uint4 xb_words;
  cg::grid_group grid = cg::this_grid();
  PP pp = (PP)__builtin_amdgcn_kernarg_segment_ptr();
  if (threadIdx.x == 0) xb_words = make_uint4(0u, 0u, 0u, 0u);
  __syncthreads();
  XcdBarrier xb = xcd_barrier_post((unsigned*)(pp->ws + S_BAR), (volatile LAS unsigned*)&xb_words);
  int nsync = 0;
  if (ph_lo < 0) grid.sync();
  bool first = true;
  for (int ph = ph_lo; ph < ph_hi; ++ph) {
    if (phase_empty(ph)) continue;
    if (!first) {
      xcd_barrier(xb);
      ++nsync;
    }
    first = false;
    PP q = pp; asm volatile("" : "+s"(q));
    run_phase(q, ph, lds);
  }
}

extern "C" void kernel_launch(void* const* d_in, const int* in_sizes, int n_in, void* d_out, int out_size, void* d_ws, size_t ws_size, hipStream_t stream) {
  static int grid_blocks = 0;
  if (grid_blocks == 0) {
    if (n_in != N_IN || ws_size < WS_NEED) { fprintf(stderr, "kernel_launch: unexpected n_in %d / ws %zu\n", n_in, ws_size); grid_blocks = -1; return; }
    int dev = 0, cus = 0, per_cu = 0;
    hipGetDevice(&dev);
    hipDeviceGetAttribute(&cus, hipDeviceAttributeMultiprocessorCount, dev);
    if (hipFuncSetAttribute((const void*)mega_kernel, hipFuncAttributeMaxDynamicSharedMemorySize, LDS_BYTES) != hipSuccess) { fprintf(stderr, "hipFuncSetAttribute failed\n"); }
    hipOccupancyMaxActiveBlocksPerMultiprocessor(&per_cu, (const void*)mega_kernel, 256, LDS_BYTES);
    if (per_cu < 1) per_cu = 1;
    if (per_cu > 2) per_cu = 2;
    grid_blocks = cus * per_cu;
    fprintf(stderr, "kernel_launch: cus %d per_cu %d grid %d\n", cus, per_cu, grid_blocks);
  }
  if (grid_blocks < 0) return;
  Params p{};
  for (int i = 0; i < N_IN; ++i) p.in[i] = (const float*)d_in[i];
  p.out = (float*)d_out; p.ws = (unsigned char*)d_ws;
  if (hipMemsetAsync((unsigned char*)d_ws + S_BAR, 0, 16384, stream) != hipSuccess) { fprintf(stderr, "memset of barrier words failed\n"); return; }
#if MEGA
  int lo = 0, hi = 2 * NPH;
  void* args[] = {&p, &lo, &hi};
  hipError_t e = hipLaunchCooperativeKernel((const void*)mega_kernel, dim3(grid_blocks), dim3(256), args, LDS_BYTES, stream);
  if (e != hipSuccess) fprintf(stderr, "cooperative launch failed: %s\n", hipGetErrorString(e));
#else
  for (int ph = 0; ph < 2 * NPH; ++ph) {
    if (phase_empty(ph)) continue;
    hipLaunchKernelGGL(mega_kernel, dim3(grid_blocks), dim3(256), LDS_BYTES, stream, p, ph, ph + 1);
  }
#endif
}
```
